# Optimizing an MI355X kernel written in HIP

```python
import jax, jax.numpy as jnp
from jax import lax
import numpy as np

D_MODEL = 4096
BATCH = 2
SEQ = 4096
DEPTH = 1
DEC_BATCH = 2
DEC_SEQ = 8192
PAST_LEN = 128

HEAD_DIM = 128
ROPE_THETA = 10000.0
NORM_EPS = 1e-6
NEG_INF = -1e30

DIL_CONFIGS = ((128, 1), (512, 4), (2048, 16))
N_DIL_GROUPS = 3
A_HEADS = 8
A_WIDTH = A_HEADS * HEAD_DIM
A_QKV_WIDTH = N_DIL_GROUPS * A_WIDTH

B_Q_HEADS = 16
B_KV_HEADS = 4
B_RADIUS = 128
B_BLOCK = 128
B_Q_WIDTH = B_Q_HEADS * HEAD_DIM
B_KV_WIDTH = B_KV_HEADS * HEAD_DIM

MEM_LEN = 256
M_HEADS = 4
M_HEAD_DIM = 256
M_WIDTH = M_HEADS * M_HEAD_DIM

MIX_WIDTH = A_WIDTH + B_Q_WIDTH + M_WIDTH
N_BRANCH = 3
IN_WIDTH = 3 * A_QKV_WIDTH + B_Q_WIDTH + 2 * B_KV_WIDTH + M_WIDTH + MIX_WIDTH + N_BRANCH * D_MODEL

kernel_name = "hybrid_dilated_window_memory_encoder"


def _col_slices():
    sizes = (("a_qkv", 3 * A_QKV_WIDTH), ("b_q", B_Q_WIDTH), ("b_kv", 2 * B_KV_WIDTH), ("m_q", M_WIDTH),
             ("z_a", A_WIDTH), ("z_b", B_Q_WIDTH), ("z_m", M_WIDTH),
             ("g_a", D_MODEL), ("g_b", D_MODEL), ("g_m", D_MODEL))
    out = {}
    lo = 0
    for name, n in sizes:
        out[name] = (lo, lo + n)
        lo += n
    return out


def _branch_rows():
    return {"a": (0, A_WIDTH), "b": (A_WIDTH, A_WIDTH + B_Q_WIDTH), "m": (A_WIDTH + B_Q_WIDTH, MIX_WIDTH)}


def _proj(h, w_in, name):
    lo, hi = _col_slices()[name]
    return jnp.einsum('bsd,de->bse', h, w_in[:, lo:hi])


def _rmsnorm(x, g):
    x32 = x.astype(jnp.float32)
    y = x32 * lax.rsqrt(jnp.mean(x32 * x32, axis=-1, keepdims=True) + NORM_EPS)
    return y.astype(x.dtype) * g


def _rope(x):
    s, dh = x.shape[1], x.shape[-1]
    inv_freq = ROPE_THETA ** (-jnp.arange(0, dh, 2, dtype=jnp.float32) / dh)
    ang = jnp.arange(s, dtype=jnp.float32)[:, None] * inv_freq[None, :]
    shp = (s,) + (1,) * (x.ndim - 3) + (dh // 2,)
    cos = jnp.cos(ang).reshape(shp).astype(x.dtype)
    sin = jnp.sin(ang).reshape(shp).astype(x.dtype)
    x1, x2 = x[..., : dh // 2], x[..., dh // 2:]
    return jnp.concatenate([x1 * cos - x2 * sin, x2 * cos + x1 * sin], axis=-1)


def _banded_attention(q, k, v, radius, blk, sink=None):
    n, L, H, dh = q.shape
    hkv = k.shape[2]
    g = H // hkv
    nb = -(-L // blk)
    lp = nb * blk
    pad = lp - L
    qb = jnp.pad(q, ((0, 0), (0, pad), (0, 0), (0, 0))).reshape(n, nb, blk, hkv, g, dh)

    def windows(t):
        tp = jnp.pad(t, ((0, 0), (blk, pad + blk), (0, 0), (0, 0))).reshape(n, nb + 2, blk, hkv, dh)
        return jnp.concatenate([tp[:, :-2], tp[:, 1:-1], tp[:, 2:]], axis=2)

    kw, vw = windows(k), windows(v)
    s = jnp.einsum('nbqhgd,nbkhd->nbhgqk', qb, kw, preferred_element_type=jnp.float32) * (dh ** -0.5)
    qpos = jnp.arange(nb)[:, None] * blk + jnp.arange(blk)[None, :]
    kpos = jnp.arange(nb)[:, None] * blk - blk + jnp.arange(3 * blk)[None, :]
    valid = ((jnp.abs(qpos[:, :, None] - kpos[:, None, :]) <= radius)
             & (kpos[:, None, :] >= 0) & (kpos[:, None, :] < L))
    s = jnp.where(valid[None, :, None, None], s, NEG_INF)
    m = jnp.max(s, axis=-1, keepdims=True)
    if sink is not None:
        sk = sink.astype(jnp.float32).reshape(1, 1, hkv, g, 1, 1)
        m = jnp.maximum(m, sk)
    e = jnp.exp(s - m)
    den = jnp.sum(e, axis=-1, keepdims=True)
    if sink is not None:
        den = den + jnp.exp(sk - m)
    lse = (m + jnp.log(den))[..., 0]
    p = (e / den).astype(v.dtype)
    o = jnp.einsum('nbhgqk,nbkhd->nbqhgd', p, vw).reshape(n, lp, H, dh)[:, :L]
    lse = lse.transpose(0, 1, 4, 2, 3).reshape(n, lp, H)[:, :L]
    return o, lse


def _dilated_group(q, k, v, window, dilation):
    b, s, h, dh = q.shape
    radius = window // (2 * dilation)
    sd = s // dilation

    def split(t):
        return t.reshape(b, sd, dilation, h, dh).transpose(0, 2, 1, 3, 4).reshape(b * dilation, sd, h, dh)

    o, lse = _banded_attention(split(q), split(k), split(v), radius, radius)
    o = o.reshape(b, dilation, sd, h, dh).transpose(0, 2, 1, 3, 4).reshape(b, s, h, dh)
    lse = lse.reshape(b, dilation, sd, h).transpose(0, 2, 1, 3).reshape(b, s, h)
    return o, lse


def _mixer_a(h, w_in):
    b, s, _ = h.shape
    qkv = _proj(h, w_in, "a_qkv").reshape(b, s, 3, N_DIL_GROUPS, A_HEADS, HEAD_DIM)
    q, k, v = _rope(qkv[:, :, 0]), _rope(qkv[:, :, 1]), qkv[:, :, 2]
    outs, lses = [], []
    for gi, (window, dilation) in enumerate(DIL_CONFIGS):
        o, lse = _dilated_group(q[:, :, gi], k[:, :, gi], v[:, :, gi], window, dilation)
        outs.append(o)
        lses.append(lse)
    alpha = jax.nn.softmax(jnp.stack(lses, axis=0), axis=0).astype(h.dtype)
    o = alpha[0][..., None] * outs[0] + alpha[1][..., None] * outs[1] + alpha[2][..., None] * outs[2]
    return o.reshape(b, s, A_WIDTH)


def _mixer_b(h, w_in, sink):
    b, s, _ = h.shape
    q = _rope(_proj(h, w_in, "b_q").reshape(b, s, B_Q_HEADS, HEAD_DIM))
    kv = _proj(h, w_in, "b_kv").reshape(b, s, 2, B_KV_HEADS, HEAD_DIM)
    k, v = _rope(kv[:, :, 0]), kv[:, :, 1]
    o, _ = _banded_attention(q, k, v, B_RADIUS, B_BLOCK, sink)
    return o.reshape(b, s, B_Q_WIDTH)


def _memory_attn(h, mem, w_in, g_mem, w_mem_kv):
    b, s, _ = h.shape
    q = _proj(h, w_in, "m_q").reshape(b, s, M_HEADS, M_HEAD_DIM)
    kv = jnp.einsum('bmd,de->bme', _rmsnorm(mem, g_mem), w_mem_kv).reshape(b, MEM_LEN, 2, M_HEADS, M_HEAD_DIM)
    sc = jnp.einsum('bshd,bmhd->bhsm', q, kv[:, :, 0], preferred_element_type=jnp.float32) * (M_HEAD_DIM ** -0.5)
    p = jax.nn.softmax(sc, axis=-1).astype(h.dtype)
    o = jnp.einsum('bhsm,bmhd->bshd', p, kv[:, :, 1])
    return o.reshape(b, s, M_WIDTH)


def _layer(x, mem, g_norm, w_in, sink, g_mem, w_mem_kv, w_branch, w_out):
    h = _rmsnorm(x, g_norm)
    branch_out = {"a": _mixer_a(h, w_in), "b": _mixer_b(h, w_in, sink),
                  "m": _memory_attn(h, mem, w_in, g_mem, w_mem_kv)}
    rows = _branch_rows()
    u = None
    for name in ("a", "b", "m"):
        z = jax.nn.silu(_proj(h, w_in, "z_" + name))
        gate = jax.nn.sigmoid(_proj(h, w_in, "g_" + name))
        lo, hi = rows[name]
        term = gate * jnp.einsum('bse,ed->bsd', branch_out[name] * z, w_branch[lo:hi])
        u = term if u is None else u + term
    return x + jnp.einsum('bsd,de->bse', u, w_out)


def _trunk(x, mem, g_norm, w_in, attn_sink, g_mem, w_mem_kv, w_branch, w_out, g_final):
    for l in range(DEPTH):
        x = _layer(x, mem, g_norm[l], w_in[l], attn_sink[l], g_mem[l], w_mem_kv[l], w_branch[l], w_out[l])
    return _rmsnorm(x, g_final)


def setup_inputs(seed: int = 0) -> dict:
    key = jax.random.key(seed)
    ks = jax.random.split(key, 12)
    f32 = jnp.float32
    return {
        "x_prompt": jax.random.normal(ks[0], (BATCH, SEQ, D_MODEL), f32),
        "x_sample": jax.random.normal(ks[1], (DEC_BATCH, DEC_SEQ, D_MODEL), f32),
        "mem_prompt": jax.random.normal(ks[2], (BATCH, MEM_LEN, D_MODEL), f32),
        "mem_sample": jax.random.normal(ks[3], (DEC_BATCH, MEM_LEN, D_MODEL), f32),
        "g_norm": 1.0 + 0.02 * jax.random.normal(ks[4], (DEPTH, D_MODEL), f32),
        "w_in": jax.random.normal(ks[5], (DEPTH, D_MODEL, IN_WIDTH), f32) * (D_MODEL ** -0.5),
        "attn_sink": 0.5 * jax.random.normal(ks[6], (DEPTH, B_Q_HEADS), f32),
        "g_mem": 1.0 + 0.02 * jax.random.normal(ks[7], (DEPTH, D_MODEL), f32),
        "w_mem_kv": jax.random.normal(ks[8], (DEPTH, D_MODEL, 2 * M_WIDTH), f32) * (D_MODEL ** -0.5),
        "w_branch": jax.random.normal(ks[9], (DEPTH, MIX_WIDTH, D_MODEL), f32) * (MIX_WIDTH ** -0.5),
        "w_out": jax.random.normal(ks[10], (DEPTH, D_MODEL, D_MODEL), f32) * (D_MODEL ** -0.5),
        "g_final": 1.0 + 0.02 * jax.random.normal(ks[11], (D_MODEL,), f32),
    }


def reference(x_prompt, x_sample, mem_prompt, mem_sample, g_norm, w_in, attn_sink, g_mem, w_mem_kv, w_branch, w_out, g_final):
    y_prompt = _trunk(x_prompt, mem_prompt, g_norm, w_in, attn_sink, g_mem, w_mem_kv, w_branch, w_out, g_final)
    y_sample = _trunk(x_sample, mem_sample, g_norm, w_in, attn_sink, g_mem, w_mem_kv, w_branch, w_out, g_final)
    return (y_prompt, y_sample)
```

```cpp
#include <hip/hip_runtime.h>
#include <cstdio>
#include <cstdint>

#define GAS __attribute__((address_space(1)))
#define LAS __attribute__((address_space(3)))
typedef unsigned short bf16_t;
typedef short bf16x8 __attribute__((ext_vector_type(8)));
typedef float f32x4 __attribute__((ext_vector_type(4)));
typedef float f32x2 __attribute__((ext_vector_type(2)));
typedef unsigned u32x4 __attribute__((ext_vector_type(4)));
typedef unsigned u32x2 __attribute__((ext_vector_type(2)));

constexpr int DM = 4096;
constexpr int M_PROMPT = 8192, M_TOK = 24576, M_MEM = 1024, M_ALL = M_TOK + M_MEM;
constexpr int N_IN = 29696, N_KV = 2048, N_ALL = N_IN + N_KV;
constexpr int C_AQ = 0, C_AK = 3072, C_AV = 6144, C_BQ = 9216, C_BK = 11264, C_BV = 11776, C_MQ = 12288, C_ZA = 13312, C_ZB = 14336, C_ZM = 16384, C_GA = 17408, C_GB = 21504, C_GM = 25600;
constexpr float NORM_EPS = 1e-6f;
constexpr int NWAVES = 8;

constexpr size_t MiB = 1u << 20;
constexpr size_t WS_CTL = 0, CTL_ZERO_BYTES = 1 * MiB;
constexpr size_t WS_ROPE = 1 * MiB;
constexpr size_t WS_MKV = 5 * MiB;
constexpr size_t WS_WBT_A = 9 * MiB, WS_WBT_B = 17 * MiB, WS_WBT_M = 33 * MiB;
constexpr size_t WS_WOT = 41 * MiB;
constexpr size_t WS_WINT = 73 * MiB;
constexpr size_t WS_U = WS_WINT;
constexpr size_t WS_P = 321 * MiB;
constexpr size_t WS_END = 1713 * MiB;
constexpr size_t DO_H = 0, DO_AZA = 0, DO_AZB = 48 * MiB, DO_AZM = 144 * MiB, DO_OG = 192 * MiB, DO_LSE = 336 * MiB;
constexpr int CW_BAR = 4096;

constexpr int RING_BYTES = 131072;
constexpr int LDSCTL_OFF = RING_BYTES, MISC_OFF = LDSCTL_OFF + 320;
constexpr int LDS_BYTES = 147456;

__device__ __forceinline__ int lane_now() { int l; asm volatile("v_mbcnt_lo_u32_b32 %0, -1, 0\n\tv_mbcnt_hi_u32_b32 %0, -1, %0" : "=v"(l)); return l; }
__device__ __forceinline__ unsigned cvt_pk_bf16(float lo, float hi) { unsigned r; asm volatile("v_cvt_pk_bf16_f32 %0, %1, %2" : "=v"(r) : "v"(lo), "v"(hi)); return r; }
__device__ __forceinline__ float bflo(unsigned w) { return __uint_as_float(w << 16); }
__device__ __forceinline__ float bfhi(unsigned w) { return __uint_as_float(w & 0xffff0000u); }
__device__ __forceinline__ float sigmoidf_(float x) { return __builtin_amdgcn_rcpf(1.0f + __expf(-x)); }

namespace pg8 {
constexpr int BM = 256, BK = 64, HALF = 128, HTB = HALF * BK * 2, STAGE_BYTES = 8 * HTB, NXCD = 8, WGM = 8;
__host__ __device__ __forceinline__ int lds_byte(int r, int c) { const int st = (r >> 4) * 2 + (c >> 5), rr = r & 15, cc = c & 31, ob = rr * 64 + cc * 2; return st * 1024 + (ob ^ (((ob >> 9) & 1) << 5)); }
__host__ __device__ __forceinline__ void stage_rc(int b, int& R, int& C) { const int st = b / 1024, sb = b % 1024, swz = sb ^ (((sb >> 9) & 1) << 5); R = (st >> 1) * 16 + swz / 64; C = (st & 1) * 32 + (swz % 64) / 2; }

struct Unit { int pm, pn; };
struct Gemm { const bf16_t* A; const bf16_t* Bt; int lda, ldb, K; };

struct StaticOrder {
    int nM, nN, nwg, G, c, extra, xm0, xn0, xw;
    __device__ void init(int nM_, int nN_, int G_, int c_) { nM = nM_; nN = nN_; nwg = nM * nN; G = G_; c = c_; extra = 0; xm0 = 0; xn0 = 0; xw = 1; }
    __device__ bool next(int i, Unit& u) const {
        const long L = (long)i * G + c;
        if (L >= nwg) { const int j = (int)(L - nwg); if (j >= extra) return false; u.pm = xm0 + j / xw; u.pn = xn0 + j % xw; return true; }
        int wgid = (int)L; { const int q = nwg / NXCD, r = nwg % NXCD, xcd = wgid % NXCD, off = wgid / NXCD; wgid = (xcd < r ? xcd * (q + 1) : r * (q + 1) + (xcd - r) * q) + off; }
        const int nig = WGM * nN, gid = wgid / nig, fm = gid * WGM, gsz = (nM - fm) < WGM ? (nM - fm) : WGM;
        u.pm = fm + ((wgid % nig) % gsz); u.pn = (wgid % nig) / gsz; return true;
    }
};

template <class Epi, bool ALIGN_EPI = true>
__device__ __forceinline__ void gemm_phase(LAS unsigned char* lds, const Gemm g, const StaticOrder& S, const Epi& E) {
    int tid_ = threadIdx.x; asm volatile("" : "+v"(tid_));
    const int tid = tid_, wid = __builtin_amdgcn_readfirstlane(tid >> 6), lane = tid & 63, wr = wid >> 2, wc = wid & 3, fr = lane & 15, fq = lane >> 4;
    const int K = g.K, nt = K / BK;
    unsigned voffA[2], voffB[2];
#pragma unroll
    for (int i = 0; i < 2; ++i) { int R, C; stage_rc(tid * 16 + i * 8192, R, C); voffA[i] = (unsigned)(R * g.lda + C) * 2u; voffB[i] = (unsigned)(R * g.ldb + C) * 2u; }
    const size_t kstep = (size_t)(BK * 2);
    const size_t hstepA = (size_t)HALF * g.lda * 2, hstepB = (size_t)HALF * g.ldb * 2;
    const size_t tstepA = 2 * hstepA, tstepB = 2 * hstepB;
    const unsigned ldsw = (unsigned)wid * 1024u;
    const int aoff = lds_byte(wr * 64 + fr, fq * 8), boff = lds_byte(wc * 32 + fr, fq * 8);
#define PG8_SA(b, h) (((b) * 2 + (h)) * HTB)
#define PG8_SB(b, h) ((4 + (b) * 2 + (h)) * HTB)
#define PG8_STAGE(bufoff, gbase, voff) do { _Pragma("unroll") for (int _i = 0; _i < 2; ++_i) \
        __builtin_amdgcn_global_load_lds((const unsigned*)((const char*)(gbase) + (voff)[_i]), (LAS unsigned*)(lds + (bufoff) + ldsw + _i * 8192), 16, 0, 0); } while (0)
#define PG8_LDA(dst, b, h) do { _Pragma("unroll") for (int m = 0; m < 4; ++m) _Pragma("unroll") for (int k = 0; k < 2; ++k) dst[m][k] = *(const LAS bf16x8*)(lds + PG8_SA(b, h) + aoff + m * 2048 + k * 1024); } while (0)
#define PG8_LDB(dst, b, h) do { _Pragma("unroll") for (int n = 0; n < 2; ++n) _Pragma("unroll") for (int k = 0; k < 2; ++k) dst[n][k] = *(const LAS bf16x8*)(lds + PG8_SB(b, h) + boff + n * 2048 + k * 1024); } while (0)
#define PG8_MMA(ai, bj, At, Bt) do { __builtin_amdgcn_s_setprio(1); _Pragma("unroll") for (int m = 0; m < 4; ++m) _Pragma("unroll") for (int n = 0; n < 2; ++n) _Pragma("unroll") for (int k = 0; k < 2; ++k) \
        acc[ai][bj][m][n] = __builtin_amdgcn_mfma_f32_16x16x32_bf16(Bt[n][k], At[m][k], acc[ai][bj][m][n], 0, 0, 0); __builtin_amdgcn_s_setprio(0); } while (0)
#define PG8_WAIT_V(n) asm volatile("s_waitcnt vmcnt(" #n ")" ::: "memory")
#define PG8_WAIT_L(n) asm volatile("s_waitcnt lgkmcnt(" #n ")" ::: "memory")
#define PG8_BAR __builtin_amdgcn_s_barrier()
#define PG8_SCHED __builtin_amdgcn_sched_barrier(0)
    Unit cur, nxt; int ui = 0;
    if (!S.next(0, cur)) return;
    f32x4 acc[2][2][4][2];
#pragma unroll
    for (int a = 0; a < 2; ++a)
#pragma unroll
        for (int b = 0; b < 2; ++b)
#pragma unroll
            for (int m = 0; m < 4; ++m)
#pragma unroll
                for (int n = 0; n < 2; ++n) acc[a][b][m][n] = (f32x4){0.f, 0.f, 0.f, 0.f};
    bf16x8 At[4][2], B0[2][2], B1[2][2];
    const char* cA = (const char*)g.A + (size_t)cur.pm * tstepA; const char* cB = (const char*)g.Bt + (size_t)cur.pn * tstepB;
    PG8_STAGE(PG8_SB(0, 0), cB, voffB); PG8_STAGE(PG8_SB(0, 1), cB + hstepB, voffB); PG8_STAGE(PG8_SA(0, 0), cA, voffA); PG8_STAGE(PG8_SA(0, 1), cA + hstepA, voffA);
    if (wr == 1) PG8_BAR;
    PG8_WAIT_V(2); PG8_BAR;
    PG8_STAGE(PG8_SB(1, 0), cB + kstep, voffB); PG8_STAGE(PG8_SA(1, 0), cA + kstep, voffA); PG8_STAGE(PG8_SB(1, 1), cB + hstepB + kstep, voffB);
    PG8_WAIT_V(6); PG8_BAR;
    for (;;) {
        const bool has_next = S.next(ui + 1, nxt);
        const char* nA = has_next ? (const char*)g.A + (size_t)nxt.pm * tstepA : cA; const char* nB = has_next ? (const char*)g.Bt + (size_t)nxt.pn * tstepB : cB;
        for (int t = 0; t < nt; t += 2) {
            if constexpr (Epi::HAS_MID) { if (t == Epi::MID0 || t == Epi::MID1) E.mid(acc, cur, t, wr, wc); }
            const bool last = (t == nt - 2);
            const char* a1 = cA + (size_t)(t + 1) * kstep;
            const char* a2 = last ? nA : cA + (size_t)(t + 2) * kstep; const char* b2 = last ? nB : cB + (size_t)(t + 2) * kstep;
            const char* a3 = a2 + kstep; const char* b3 = b2 + kstep;
            PG8_LDB(B0, 0, 0); PG8_LDB(B1, 0, 1); PG8_SCHED; PG8_LDA(At, 0, 0); PG8_STAGE(PG8_SA(1, 1), a1 + hstepA, voffA);
            PG8_WAIT_V(8); PG8_WAIT_L(0); PG8_BAR; PG8_MMA(0, 0, At, B0); PG8_MMA(0, 1, At, B1); PG8_BAR; PG8_SCHED;
            PG8_LDA(At, 0, 1); PG8_STAGE(PG8_SB(0, 0), b2, voffB); PG8_STAGE(PG8_SB(0, 1), b2 + hstepB, voffB); PG8_STAGE(PG8_SA(0, 0), a2, voffA);
            PG8_WAIT_V(8); PG8_WAIT_L(0); PG8_BAR; PG8_MMA(1, 0, At, B0); PG8_MMA(1, 1, At, B1); PG8_BAR; PG8_SCHED;
            PG8_LDB(B0, 1, 0); PG8_LDB(B1, 1, 1); PG8_SCHED; PG8_LDA(At, 1, 0); PG8_STAGE(PG8_SA(0, 1), a2 + hstepA, voffA);
            PG8_WAIT_V(8); PG8_WAIT_L(0); PG8_BAR; PG8_MMA(0, 0, At, B0); PG8_MMA(0, 1, At, B1); PG8_BAR; PG8_SCHED;
            PG8_LDA(At, 1, 1); PG8_STAGE(PG8_SB(1, 0), b3, voffB); PG8_STAGE(PG8_SB(1, 1), b3 + hstepB, voffB); PG8_STAGE(PG8_SA(1, 0), a3, voffA);
            PG8_WAIT_V(8); PG8_WAIT_L(0); PG8_BAR; PG8_MMA(1, 0, At, B0); PG8_MMA(1, 1, At, B1); PG8_BAR; PG8_SCHED;
        }
        if constexpr (ALIGN_EPI) { if (wr == 0) PG8_BAR; }
        E(acc, cur, wr, wc, fr, fq);
        if (!has_next) break;
#pragma unroll
        for (int a = 0; a < 2; ++a)
#pragma unroll
            for (int b = 0; b < 2; ++b)
#pragma unroll
                for (int m = 0; m < 4; ++m)
#pragma unroll
                    for (int n = 0; n < 2; ++n) acc[a][b][m][n] = (f32x4){0.f, 0.f, 0.f, 0.f};
        cur = nxt; cA = nA; cB = nB; ++ui;
        if constexpr (ALIGN_EPI) { if (wr == 1) PG8_BAR; }
    }
    PG8_WAIT_V(0);
    if constexpr (!ALIGN_EPI) { if (wr == 0) PG8_BAR; }
    PG8_BAR;
#undef PG8_SA
#undef PG8_SB
#undef PG8_STAGE
#undef PG8_LDA
#undef PG8_LDB
#undef PG8_MMA
#undef PG8_WAIT_V
#undef PG8_WAIT_L
#undef PG8_BAR
#undef PG8_SCHED
}
}

__device__ __forceinline__ int tile_type(int pn) {
    if (pn < 24) return 1; if (pn < 36) return 0; if (pn < 46) return 1; if (pn < 52) return 0; if (pn < 68) return 2; if (pn < 116) return 3; return 0;
}
struct EpiProj {
    static constexpr bool HAS_MID = false; static constexpr int MID0 = -1, MID1 = -1;
    bf16_t* P; bf16_t* MKV; const f32x4* rope;
    __device__ __forceinline__ void operator()(const f32x4 (&acc)[2][2][4][2], const pg8::Unit& u, int wr, int wc, int fr, int fq) const {
        if (u.pm >= 96) {
            const int row0 = (u.pm - 96) * 256 + wr * 64 + fr, col0 = (u.pn - 116) * 256 + wc * 32 + 8 * fq;
#pragma unroll
            for (int ai = 0; ai < 2; ++ai)
#pragma unroll
                for (int m = 0; m < 4; ++m) { bf16_t* rowp = MKV + (size_t)(row0 + ai * 128 + m * 16) * N_KV + col0;
#pragma unroll
                    for (int bj = 0; bj < 2; ++bj) { const f32x4 v0 = acc[ai][bj][m][0], v1 = acc[ai][bj][m][1];
                        u32x4 w; w.x = cvt_pk_bf16(v0[0], v0[1]); w.y = cvt_pk_bf16(v0[2], v0[3]); w.z = cvt_pk_bf16(v1[0], v1[1]); w.w = cvt_pk_bf16(v1[2], v1[3]);
                        *(u32x4*)(rowp + bj * 128) = w; } }
            return;
        }
        const int ty = tile_type(u.pn);
        const int row0 = u.pm * 256 + wr * 64 + fr;
        if (ty == 1) {
#pragma unroll
            for (int ai = 0; ai < 2; ++ai)
#pragma unroll
                for (int m = 0; m < 4; ++m) {
                    const int row = row0 + ai * 128 + m * 16; const int pos = row < M_PROMPT ? (row & 4095) : (row & 8191);
                    const f32x4* t = rope + (size_t)pos * 32 + 8 * wc + 2 * fq; const f32x4 t0 = t[0], t1 = t[1];
                    bf16_t* rowp = P + (size_t)row * N_IN + u.pn * 256 + 16 * wc + 4 * fq;
#pragma unroll
                    for (int bj = 0; bj < 2; ++bj) { const f32x4 x1 = acc[ai][bj][m][0], x2 = acc[ai][bj][m][1];
                        const float l0 = x1[0] * t0[0] - x2[0] * t0[1], h0 = x2[0] * t0[0] + x1[0] * t0[1];
                        const float l1 = x1[1] * t0[2] - x2[1] * t0[3], h1 = x2[1] * t0[2] + x1[1] * t0[3];
                        const float l2 = x1[2] * t1[0] - x2[2] * t1[1], h2 = x2[2] * t1[0] + x1[2] * t1[1];
                        const float l3 = x1[3] * t1[2] - x2[3] * t1[3], h3 = x2[3] * t1[2] + x1[3] * t1[3];
                        u32x2 lo, hi; lo.x = cvt_pk_bf16(l0, l1); lo.y = cvt_pk_bf16(l2, l3); hi.x = cvt_pk_bf16(h0, h1); hi.y = cvt_pk_bf16(h2, h3);
                        *(u32x2*)(rowp + bj * 128) = lo; *(u32x2*)(rowp + bj * 128 + 64) = hi; }
                }
            return;
        }
#pragma unroll
        for (int ai = 0; ai < 2; ++ai)
#pragma unroll
            for (int m = 0; m < 4; ++m) { bf16_t* rowp = P + (size_t)(row0 + ai * 128 + m * 16) * N_IN + u.pn * 256 + wc * 32 + 8 * fq;
#pragma unroll
                for (int bj = 0; bj < 2; ++bj) { f32x4 v0 = acc[ai][bj][m][0], v1 = acc[ai][bj][m][1];
                    if (ty == 2) {
#pragma unroll
                        for (int j = 0; j < 4; ++j) { v0[j] = v0[j] * sigmoidf_(v0[j]); v1[j] = v1[j] * sigmoidf_(v1[j]); } }
                    else if (ty == 3) {
#pragma unroll
                        for (int j = 0; j < 4; ++j) { v0[j] = sigmoidf_(v0[j]); v1[j] = sigmoidf_(v1[j]); } }
                    u32x4 w; w.x = cvt_pk_bf16(v0[0], v0[1]); w.y = cvt_pk_bf16(v0[2], v0[3]); w.z = cvt_pk_bf16(v1[0], v1[1]); w.w = cvt_pk_bf16(v1[2], v1[3]);
                    *(u32x4*)(rowp + bj * 128) = w; } }
    }
};
struct EpiBranch {
    static constexpr bool HAS_MID = false; static constexpr int MID0 = -1, MID1 = -1;
    const bf16_t* G; bf16_t* U; int first;
    __device__ __forceinline__ void operator()(const f32x4 (&acc)[2][2][4][2], const pg8::Unit& u, int wr, int wc, int fr, int fq) const {
        const int row0 = u.pm * 256 + wr * 64 + fr, col0 = u.pn * 256 + wc * 32 + 8 * fq;
#pragma unroll
        for (int ai = 0; ai < 2; ++ai)
#pragma unroll
            for (int m = 0; m < 4; ++m) { const int row = row0 + ai * 128 + m * 16; const bf16_t* gp = G + (size_t)row * N_IN + col0; bf16_t* up = U + (size_t)row * DM + col0;
#pragma unroll
                for (int bj = 0; bj < 2; ++bj) { const u32x4 gw = *(const u32x4*)(gp + bj * 128); f32x4 v0 = acc[ai][bj][m][0], v1 = acc[ai][bj][m][1];
                    v0[0] *= bflo(gw.x); v0[1] *= bfhi(gw.x); v0[2] *= bflo(gw.y); v0[3] *= bfhi(gw.y); v1[0] *= bflo(gw.z); v1[1] *= bfhi(gw.z); v1[2] *= bflo(gw.w); v1[3] *= bfhi(gw.w);
                    if (!first) { const u32x4 pw = *(const u32x4*)(up + bj * 128);
                        v0[0] += bflo(pw.x); v0[1] += bfhi(pw.x); v0[2] += bflo(pw.y); v0[3] += bfhi(pw.y); v1[0] += bflo(pw.z); v1[1] += bfhi(pw.z); v1[2] += bflo(pw.w); v1[3] += bfhi(pw.w); }
                    u32x4 w; w.x = cvt_pk_bf16(v0[0], v0[1]); w.y = cvt_pk_bf16(v0[2], v0[3]); w.z = cvt_pk_bf16(v1[0], v1[1]); w.w = cvt_pk_bf16(v1[2], v1[3]);
                    *(u32x4*)(up + bj * 128) = w; }
                asm volatile("" ::: "memory"); }
    }
};
struct EpiBranchFused {
    static constexpr bool HAS_MID = true; static constexpr int MID0 = 16, MID1 = 48;
    const bf16_t* P; bf16_t* U;
    __device__ __forceinline__ void mid(f32x4 (&acc)[2][2][4][2], const pg8::Unit& u, int t, int wr, int wc) const {
        const int l_ = lane_now(), fr = l_ & 15, fq = l_ >> 4;
        const int row0 = u.pm * 256 + wr * 64 + fr, col0 = u.pn * 256 + wc * 32 + 8 * fq;
        const int cnum = t == MID0 ? C_GA : C_GB, cden = t == MID0 ? C_GB : C_GM;
#pragma unroll
        for (int ai = 0; ai < 2; ++ai)
#pragma unroll
            for (int m = 0; m < 4; ++m) { const bf16_t* gp = P + (size_t)(row0 + ai * 128 + m * 16) * N_IN + col0;
#pragma unroll
                for (int bj = 0; bj < 2; ++bj) { const u32x4 gn = *(const u32x4*)(gp + cnum + bj * 128), gd = *(const u32x4*)(gp + cden + bj * 128);
#define RAT(a, b) ((a) * __builtin_amdgcn_rcpf(fmaxf((b), 1e-30f)))
                    f32x4& v0 = acc[ai][bj][m][0]; f32x4& v1 = acc[ai][bj][m][1];
                    v0[0] *= RAT(bflo(gn.x), bflo(gd.x)); v0[1] *= RAT(bfhi(gn.x), bfhi(gd.x)); v0[2] *= RAT(bflo(gn.y), bflo(gd.y)); v0[3] *= RAT(bfhi(gn.y), bfhi(gd.y));
                    v1[0] *= RAT(bflo(gn.z), bflo(gd.z)); v1[1] *= RAT(bfhi(gn.z), bfhi(gd.z)); v1[2] *= RAT(bflo(gn.w), bflo(gd.w)); v1[3] *= RAT(bfhi(gn.w), bfhi(gd.w));
#undef RAT
                }
                asm volatile("" ::: "memory"); }
    }
    __device__ __forceinline__ void operator()(const f32x4 (&acc)[2][2][4][2], const pg8::Unit& u, int wr, int wc, int fr, int fq) const {
        const int row0 = u.pm * 256 + wr * 64 + fr, col0 = u.pn * 256 + wc * 32 + 8 * fq;
#pragma unroll
        for (int ai = 0; ai < 2; ++ai)
#pragma unroll
            for (int m = 0; m < 4; ++m) { const int row = row0 + ai * 128 + m * 16; const bf16_t* gp = P + (size_t)row * N_IN + C_GM + col0; bf16_t* up = U + (size_t)row * DM + col0;
#pragma unroll
                for (int bj = 0; bj < 2; ++bj) { const u32x4 gw = *(const u32x4*)(gp + bj * 128); f32x4 v0 = acc[ai][bj][m][0], v1 = acc[ai][bj][m][1];
                    v0[0] *= bflo(gw.x); v0[1] *= bfhi(gw.x); v0[2] *= bflo(gw.y); v0[3] *= bfhi(gw.y); v1[0] *= bflo(gw.z); v1[1] *= bfhi(gw.z); v1[2] *= bflo(gw.w); v1[3] *= bfhi(gw.w);
                    u32x4 w; w.x = cvt_pk_bf16(v0[0], v0[1]); w.y = cvt_pk_bf16(v0[2], v0[3]); w.z = cvt_pk_bf16(v1[0], v1[1]); w.w = cvt_pk_bf16(v1[2], v1[3]);
                    *(u32x4*)(up + bj * 128) = w; }
                asm volatile("" ::: "memory"); }
    }
};
struct EpiOut {
    static constexpr bool HAS_MID = false; static constexpr int MID0 = -1, MID1 = -1;
    const float* xp; const float* xs; float* out;
    __device__ __forceinline__ void operator()(const f32x4 (&acc)[2][2][4][2], const pg8::Unit& u, int wr, int wc, int fr, int fq) const {
        const int row0 = u.pm * 256 + wr * 64 + fr, col0 = u.pn * 256 + wc * 32 + 4 * fq;
#pragma unroll
        for (int ai = 0; ai < 2; ++ai)
#pragma unroll
            for (int m = 0; m < 4; ++m) { const int row = row0 + ai * 128 + m * 16;
                const float* xr = (row < M_PROMPT ? xp + (size_t)row * DM : xs + (size_t)(row - M_PROMPT) * DM) + col0; float* orow = out + (size_t)row * DM + col0;
#pragma unroll
                for (int bj = 0; bj < 2; ++bj)
#pragma unroll
                    for (int n = 0; n < 2; ++n) { const f32x4 xv = *(const f32x4*)(xr + bj * 128 + n * 16); *(f32x4*)(orow + bj * 128 + n * 16) = xv + acc[ai][bj][m][n]; }
                asm volatile("" ::: "memory"); }
    }
};

#define XB_TMO      128
#define XB_XCNT(j)  (256  + 64 * (j))
#define XB_XSUB(j)  (1280 + 64 * (j))
#define XB_XGEN(j)  (2304 + 64 * (j))
#define XB_TOP      3328
#define XB_TOPGEN   3392
#define XCD_BAR_WORDS 3456
#define XB_SPIN_CAP (1u << 18)
__device__ __forceinline__ unsigned xb_ld(unsigned* p)              { return __hip_atomic_load(p, __ATOMIC_RELAXED, __HIP_MEMORY_SCOPE_AGENT); }
__device__ __forceinline__ unsigned xb_add(unsigned* p, unsigned v) { return __hip_atomic_fetch_add(p, v, __ATOMIC_RELAXED, __HIP_MEMORY_SCOPE_AGENT); }
__device__ __forceinline__ unsigned xb_xcc_id() { return (unsigned)__builtin_amdgcn_s_getreg((3 << 11) | 20) & 0xFu; }
#define XB_SPIN(cond, bar) do { unsigned _sp = 0; while (cond) { __builtin_amdgcn_s_sleep(1); \
    if ((++_sp & 255u) == 0u) { if (xb_ld(&(bar)[XB_TMO])) break; if (_sp > XB_SPIN_CAP) { atomicAdd(&(bar)[XB_TMO], 1u); break; } } } } while (0)
struct XcdBarrier { unsigned* bar; unsigned x; volatile LAS unsigned* st; };
__device__ __forceinline__ XcdBarrier xcd_barrier_post(unsigned* bar, volatile LAS unsigned* st) {
    XcdBarrier b; b.bar = bar; b.x = xb_xcc_id(); b.st = st;
    if (threadIdx.x == 0) (void)xb_add(&bar[XB_XCNT(b.x)], 1u);
    return b;
}
__device__ __forceinline__ void xcd_barrier_complete(unsigned* bar, unsigned x, unsigned& nloc, unsigned& nx) {
    const unsigned G = gridDim.x * gridDim.y * gridDim.z;
    unsigned sum, cnt, mine, sp = 0u;
    for (;;) {
        sum = 0u; cnt = 0u; mine = 0u;
#pragma unroll
        for (unsigned j = 0; j < 16; ++j) { const unsigned c = xb_ld(&bar[XB_XCNT(j)]); sum += c; cnt += (c > 0u) ? 1u : 0u; mine = (j == x) ? c : mine; }
        if (sum == G) break;
        __builtin_amdgcn_s_sleep(1);
        if ((++sp & 255u) == 0u) { if (xb_ld(&bar[XB_TMO])) break; if (sp > XB_SPIN_CAP) { atomicAdd(&bar[XB_TMO], 1u); break; } }
    }
    nloc = mine > 0u ? mine : 1u; nx = cnt > 0u ? cnt : 1u;
}
__device__ __forceinline__ void xcd_barrier(const XcdBarrier& b) {
    asm volatile("s_waitcnt vmcnt(0)" ::: "memory");
    __syncthreads();
    if (threadIdx.x == 0) {
        unsigned* bar = b.bar;
        __builtin_amdgcn_s_waitcnt(0);
        unsigned nloc = b.st[0], nx = b.st[1];
        if (nloc == 0u) { xcd_barrier_complete(bar, b.x, nloc, nx); b.st[0] = nloc; b.st[1] = nx; }
        const unsigned old = xb_add(&bar[XB_XSUB(b.x)], 1u);
        const unsigned gen = old / nloc;
        if (old + 1u == (gen + 1u) * nloc) {
            __builtin_amdgcn_fence(__ATOMIC_RELEASE, "agent");
            asm volatile("s_waitcnt vmcnt(0)" ::: "memory");
            const unsigned og = xb_add(&bar[XB_TOP], 1u);
            const unsigned tg = og / nx;
            if (og + 1u == (tg + 1u) * nx) xb_add(&bar[XB_TOPGEN], 1u);
            else XB_SPIN(xb_ld(&bar[XB_TOPGEN]) == tg, bar);
            __builtin_amdgcn_fence(__ATOMIC_ACQUIRE, "agent");
            xb_add(&bar[XB_XGEN(b.x)], 1u);
            asm volatile("s_waitcnt vmcnt(0)" ::: "memory");
        } else {
            XB_SPIN(xb_ld(&bar[XB_XGEN(b.x)]) == gen, bar);
            __builtin_amdgcn_fence(__ATOMIC_ACQUIRE, "agent");
            asm volatile("s_waitcnt vmcnt(0)" ::: "memory");
        }
    }
    __syncthreads();
}

#define LDS_WAIT() asm volatile("s_waitcnt lgkmcnt(0)" ::: "memory")
__device__ __forceinline__ float wave_sum(float v) {
#pragma unroll
    for (int o = 1; o < 64; o <<= 1) v += __shfl_xor(v, o);
    return v;
}
__device__ __forceinline__ float wave_max(float v) {
#pragma unroll
    for (int o = 1; o < 64; o <<= 1) v = fmaxf(v, __shfl_xor(v, o));
    return v;
}
__device__ __forceinline__ int perm_std(int n) { const int s = n & 31; return (n & ~31) + 16 * ((s >> 2) & 1) + 4 * (s >> 3) + (s & 3); }
__device__ __forceinline__ int perm_rope(int n) { const int d = n & 127; return (n & ~127) + 32 * ((d & 63) >> 4) + 16 * (d >> 6) + (d & 15); }
__device__ __forceinline__ void transpose_item(const float* W, int ldw, int k0, int n0, bf16_t* WT, int ldt, int kdst0, int mode, LAS float* scr, int lane) {
#pragma unroll 8
    for (int i = 0; i < 32; ++i) { const int kk = 2 * i + (lane >> 5); scr[kk * 33 + (lane & 31)] = W[(size_t)(k0 + kk) * ldw + n0 + (lane & 31)]; }
    LDS_WAIT(); asm volatile("" ::: "memory");
    const int c = lane & 7;
#pragma unroll
    for (int j = 0; j < 4; ++j) { const int n = (lane >> 3) + 8 * j; const LAS float* s = scr + (8 * c) * 33 + n;
        u32x4 o; o.x = cvt_pk_bf16(s[0 * 33], s[1 * 33]); o.y = cvt_pk_bf16(s[2 * 33], s[3 * 33]); o.z = cvt_pk_bf16(s[4 * 33], s[5 * 33]); o.w = cvt_pk_bf16(s[6 * 33], s[7 * 33]);
        const int ns = n0 + n; int nd = ns;
        if (mode == 1) nd = perm_std(ns); else if (mode == 2) nd = (tile_type(ns >> 8) == 1) ? perm_rope(ns) : perm_std(ns);
        *(u32x4*)(WT + (size_t)nd * ldt + kdst0 + 8 * c) = o; }
    LDS_WAIT(); asm volatile("" ::: "memory");
}
__device__ __forceinline__ void rms_row_to_bf16(const float* xrow, const float* gain, bf16_t* orow, int lane) {
    const f32x4* xr = (const f32x4*)xrow + lane; f32x4 v[16]; float s = 0.f;
#pragma unroll
    for (int j = 0; j < 16; ++j) { v[j] = xr[64 * j]; s += (v[j][0] * v[j][0] + v[j][1] * v[j][1]) + (v[j][2] * v[j][2] + v[j][3] * v[j][3]); }
    const float rstd = 1.0f / sqrtf(wave_sum(s) * (1.0f / DM) + NORM_EPS);
    const f32x4* gr = (const f32x4*)gain + lane; u32x2* o = (u32x2*)orow + lane;
#pragma unroll
    for (int j = 0; j < 16; ++j) { const f32x4 g = gr[64 * j]; u32x2 w; w.x = cvt_pk_bf16(v[j][0] * rstd * g[0], v[j][1] * rstd * g[1]); w.y = cvt_pk_bf16(v[j][2] * rstd * g[2], v[j][3] * rstd * g[3]); o[64 * j] = w; }
}


#ifndef SELFCHECK
#define SELFCHECK 0
#endif
__device__ __forceinline__ float bf1(const bf16_t* p) { return __uint_as_float(((unsigned)*p) << 16); }
__device__ __forceinline__ float rbf(float x) { return bflo(cvt_pk_bf16(x, 0.f) & 0xffffu); }
__device__ __forceinline__ float dot_bf16(const bf16_t* a, const bf16_t* b, int K, float& sabs) {
    float s = 0.f; sabs = 0.f;
    for (int k = 0; k < K; k += 8) { const u32x4 av = *(const u32x4*)(a + k), bv = *(const u32x4*)(b + k);
        float p;
        p = bflo(av.x) * bflo(bv.x); s += p; sabs += fabsf(p); p = bfhi(av.x) * bfhi(bv.x); s += p; sabs += fabsf(p);
        p = bflo(av.y) * bflo(bv.y); s += p; sabs += fabsf(p); p = bfhi(av.y) * bfhi(bv.y); s += p; sabs += fabsf(p);
        p = bflo(av.z) * bflo(bv.z); s += p; sabs += fabsf(p); p = bfhi(av.z) * bfhi(bv.z); s += p; sabs += fabsf(p);
        p = bflo(av.w) * bflo(bv.w); s += p; sabs += fabsf(p); p = bfhi(av.w) * bfhi(bv.w); s += p; sabs += fabsf(p); }
    return s;
}
__device__ __forceinline__ unsigned hash32(unsigned x) { x ^= x >> 16; x *= 0x7feb352du; x ^= x >> 15; x *= 0x846ca68bu; x ^= x >> 16; return x; }
__device__ __forceinline__ int win_dest_row(int n) { return (tile_type(n >> 8) == 1) ? perm_rope(n) : perm_std(n); }

namespace att {
typedef float f32x16 __attribute__((ext_vector_type(16)));
typedef short s16x4 __attribute__((ext_vector_type(4)));
#define ATT_KSWZ(row, colB) ((row) * 256 + ((colB) ^ (((row) & 7) << 4)))
constexpr int BUF_BYTES = 49152, K0_OFF = 0, K1_OFF = 16384, V_OFF = 32768, WSCR_OFF = 2 * BUF_BYTES;
__device__ __forceinline__ int crow(int r, int hi) { return (r & 3) + 8 * (r >> 2) + 4 * hi; }
__device__ __forceinline__ int v_st(int k, int c) { const int kk = (k & ~0xC) | ((k & 4) << 1) | ((k & 8) >> 1); return ((kk >> 3) * 4 + (c >> 5)) * 512 + ((kk & 7) * 32 + (c & 31)) * 2; }
__device__ __forceinline__ int v_rd_base(int lane) { return ((lane & 3) << 3) | (((lane >> 2) & 3) << 6) | (((lane >> 4) & 1) << 5) | (((lane >> 5) & 1) << 8); }
constexpr int v_rd_off(int d0, int ks, int half) { return d0 * 512 + ks * 4096 + half * 2048; }
template <int OFF> __device__ __forceinline__ s16x4 tr_read(const LAS unsigned char* vb) { return __builtin_amdgcn_ds_read_tr16_b64_v4i16((LAS s16x4*)(vb + OFF)); }
template <int D0> __device__ __forceinline__ void pv_one(f32x16& od, const LAS unsigned char* vb, bf16x8 pa0, bf16x8 pa1, bf16x8 pa2, bf16x8 pa3) {
    const s16x4 l0 = tr_read<v_rd_off(D0, 0, 0)>(vb), h0 = tr_read<v_rd_off(D0, 0, 1)>(vb), l1 = tr_read<v_rd_off(D0, 1, 0)>(vb), h1 = tr_read<v_rd_off(D0, 1, 1)>(vb);
    const s16x4 l2 = tr_read<v_rd_off(D0, 2, 0)>(vb), h2 = tr_read<v_rd_off(D0, 2, 1)>(vb), l3 = tr_read<v_rd_off(D0, 3, 0)>(vb), h3 = tr_read<v_rd_off(D0, 3, 1)>(vb);
#define ATT_PK(L, H) (bf16x8){L[0], L[1], L[2], L[3], H[0], H[1], H[2], H[3]}
    od = __builtin_amdgcn_mfma_f32_32x32x16_bf16(ATT_PK(l0, h0), pa0, od, 0, 0, 0);
    od = __builtin_amdgcn_mfma_f32_32x32x16_bf16(ATT_PK(l1, h1), pa1, od, 0, 0, 0);
    od = __builtin_amdgcn_mfma_f32_32x32x16_bf16(ATT_PK(l2, h2), pa2, od, 0, 0, 0);
    od = __builtin_amdgcn_mfma_f32_32x32x16_bf16(ATT_PK(l3, h3), pa3, od, 0, 0, 0);
#undef ATT_PK
}
__device__ __forceinline__ void qkt_acc(f32x16& p0, f32x16& p1, const LAS unsigned char* Ks, const bf16x8* qr, int r32, int hi) {
#pragma unroll
    for (int d0 = 0; d0 < 8; ++d0) { const int cb = (d0 * 16 + hi * 8) * 2;
        const bf16x8 b0 = *(const LAS bf16x8*)(Ks + ATT_KSWZ(r32, cb));
        const bf16x8 b1 = *(const LAS bf16x8*)(Ks + ATT_KSWZ(32 + r32, cb));
        p0 = __builtin_amdgcn_mfma_f32_32x32x16_bf16(b0, qr[d0], p0, 0, 0, 0);
        p1 = __builtin_amdgcn_mfma_f32_32x32x16_bf16(b1, qr[d0], p1, 0, 0, 0); }
}
template <int DQK, int R>
__device__ __forceinline__ void attn_unit(LAS unsigned char* lds, int tid, int wave, int lane,
                                          const bf16_t* qlane  , const bf16_t* kbase, const bf16_t* vbase, size_t kvstride  ,
                                          int kt0, int ntiles, int jw  , float C  , float thr_raw  ,
                                          f32x16 (&o)[4], float& m_reg, float& l_reg) {
    constexpr int NKC = DQK / 128;
    const int r32 = lane & 31, hi = lane >> 5;
    bf16x8 qr[8 * NKC];
#pragma unroll
    for (int c = 0; c < 8 * NKC; ++c) qr[c] = *(const bf16x8*)(qlane + 16 * c);
    unsigned koff[2], voff[2];
#pragma unroll
    for (int i = 0; i < 2; ++i) { const int b = i * 8192 + tid * 16;
        { const int row = b >> 8, colB = (b & 255) ^ ((row & 7) << 4); koff[i] = (unsigned)(((size_t)row * kvstride + (colB >> 1)) * 2); }
        { const int sub = b >> 9, within = (b & 511) >> 1, kk = (sub >> 2) * 8 + (within >> 5), k = (kk & ~0xC) | ((kk & 4) << 1) | ((kk & 8) >> 1), c = (sub & 3) * 32 + (within & 31); voff[i] = (unsigned)(((size_t)k * kvstride + c) * 2); } }
    const unsigned ldsw = (unsigned)wave * 1024u;
#define ATT_LOAD(t, b) do { const char* kp = (const char*)(kbase + (size_t)(kt0 + 64 * (t)) * kvstride); const char* vp = (const char*)(vbase + (size_t)(kt0 + 64 * (t)) * kvstride); LAS unsigned char* bb_ = lds + (b) * BUF_BYTES; \
        _Pragma("unroll") for (int c = 0; c < NKC; ++c) _Pragma("unroll") for (int i = 0; i < 2; ++i) \
            __builtin_amdgcn_global_load_lds((const unsigned*)(kp + 256 * c + koff[i]), (LAS unsigned*)(bb_ + K0_OFF + c * 16384 + i * 8192 + ldsw), 16, 0, 0); \
        _Pragma("unroll") for (int i = 0; i < 2; ++i) __builtin_amdgcn_global_load_lds((const unsigned*)(vp + voff[i]), (LAS unsigned*)(bb_ + V_OFF + i * 8192 + ldsw), 16, 0, 0); } while (0)
    __syncthreads();
    ATT_LOAD(0, 0);
    for (int t = 0; t < ntiles; ++t) {
        const int b = t & 1;
        asm volatile("s_waitcnt vmcnt(0)" ::: "memory");
        __syncthreads();
        if (t + 1 < ntiles) ATT_LOAD(t + 1, b ^ 1);
        const int kt = kt0 + 64 * t;
        if (R == 0 || (kt <= jw + 31 + R && kt + 63 >= jw - R)) {
            const LAS unsigned char* bb = lds + b * BUF_BYTES;
            f32x16 p0, p1;
#pragma unroll
            for (int r = 0; r < 16; ++r) { p0[r] = 0.f; p1[r] = 0.f; }
            qkt_acc(p0, p1, bb + K0_OFF, qr, r32, hi);
            if (NKC == 2) qkt_acc(p0, p1, bb + K1_OFF, qr + 8 * (NKC - 1), r32, hi);
            if (R != 0 && !(kt >= jw + 31 - R && kt + 63 <= jw + R)) {
                const int dq = kt - (jw + r32) + R + 4 * hi; const float NEG = -__builtin_inff();
#pragma unroll
                for (int r = 0; r < 16; ++r) { const int c = (r & 3) + 8 * (r >> 2);
                    if ((unsigned)(dq + c) > (unsigned)(2 * R)) p0[r] = NEG;
                    if ((unsigned)(dq + c + 32) > (unsigned)(2 * R)) p1[r] = NEG; }
            }
            float pmax = p0[0];
#pragma unroll
            for (int r = 1; r < 16; ++r) pmax = fmaxf(pmax, p0[r]);
#pragma unroll
            for (int r = 0; r < 16; ++r) pmax = fmaxf(pmax, p1[r]);
            { auto rr = __builtin_amdgcn_permlane32_swap(__float_as_uint(pmax), __float_as_uint(pmax), false, false); pmax = fmaxf(__uint_as_float(rr[0]), __uint_as_float(rr[1])); }
            float mn, alpha;
            if (__all(pmax - m_reg <= thr_raw)) { mn = m_reg; alpha = 1.f; }
            else { mn = fmaxf(m_reg, pmax); alpha = __builtin_amdgcn_exp2f((m_reg - mn) * C); m_reg = mn; }
            const float mnC = -mn * C; float ps = 0.f;
#pragma unroll
            for (int r = 0; r < 16; ++r) { p0[r] = __builtin_amdgcn_exp2f(fmaf(p0[r], C, mnC)); p1[r] = __builtin_amdgcn_exp2f(fmaf(p1[r], C, mnC)); ps += p0[r] + p1[r]; }
            { auto rr = __builtin_amdgcn_permlane32_swap(__float_as_uint(ps), __float_as_uint(ps), false, false); ps = __uint_as_float(rr[0]) + __uint_as_float(rr[1]); }
            l_reg = l_reg * alpha + ps;
            bf16x8 pa0, pa1, pa2, pa3;
#define ATT_PK4(Pv, B_, OUT) do { const unsigned a0 = cvt_pk_bf16(Pv[B_ + 0], Pv[B_ + 1]), a1 = cvt_pk_bf16(Pv[B_ + 2], Pv[B_ + 3]), b0 = cvt_pk_bf16(Pv[B_ + 4], Pv[B_ + 5]), b1 = cvt_pk_bf16(Pv[B_ + 6], Pv[B_ + 7]); \
        auto r0 = __builtin_amdgcn_permlane32_swap(a0, b0, false, false); auto r1 = __builtin_amdgcn_permlane32_swap(a1, b1, false, false); \
        u32x4 w = {r0[0], r1[0], r0[1], r1[1]}; OUT = __builtin_bit_cast(bf16x8, w); } while (0)
            ATT_PK4(p0, 0, pa0); ATT_PK4(p0, 8, pa1); ATT_PK4(p1, 0, pa2); ATT_PK4(p1, 8, pa3);
#undef ATT_PK4
            if (__any(alpha < 1.f)) {
#pragma unroll
                for (int r = 0; r < 16; ++r)
#pragma unroll
                    for (int d = 0; d < 4; ++d) o[d][r] *= alpha;
            }
            const LAS unsigned char* vb = bb + V_OFF + v_rd_base(lane);
            pv_one<0>(o[0], vb, pa0, pa1, pa2, pa3); pv_one<1>(o[1], vb, pa0, pa1, pa2, pa3); pv_one<2>(o[2], vb, pa0, pa1, pa2, pa3); pv_one<3>(o[3], vb, pa0, pa1, pa2, pa3);
        }
    }
#undef ATT_LOAD
}
__device__ __forceinline__ void row_inv(LAS unsigned char* lds, int wave, int lane, float l_reg, float (&rli)[16]) {
    LAS float* li_l = (LAS float*)(lds + WSCR_OFF + wave * 256 + 128); const int r32 = lane & 31, hi = lane >> 5;
    if (hi == 0) li_l[r32] = l_reg;
    asm volatile("s_waitcnt lgkmcnt(0)" ::: "memory");
#pragma unroll
    for (int r = 0; r < 16; ++r) rli[r] = __builtin_amdgcn_rcpf(li_l[crow(r, hi)]);
    asm volatile("s_waitcnt lgkmcnt(0)" ::: "memory");
}
__device__ __forceinline__ void st_bf16(bf16_t* p, float v) { *p = (bf16_t)(cvt_pk_bf16(v, 0.f) & 0xffffu); }
template <class F>
__device__ __forceinline__ void emit_rows(LAS unsigned char* slab, int lane, const f32x16 (&o)[4], float rl, F emit) {
    const int r32 = lane & 31, hi = lane >> 5;
#pragma unroll
    for (int h = 0; h < 2; ++h) {
#pragma unroll
        for (int dd = 0; dd < 2; ++dd)
#pragma unroll
            for (int g = 0; g < 4; ++g) { const int d = 2 * h + dd; u32x2 w; w.x = cvt_pk_bf16(o[d][4 * g + 0] * rl, o[d][4 * g + 1] * rl); w.y = cvt_pk_bf16(o[d][4 * g + 2] * rl, o[d][4 * g + 3] * rl);
                *(LAS u32x2*)(slab + r32 * 144 + (32 * dd + 8 * g + 4 * hi) * 2) = w; }
#pragma unroll
        for (int i = 0; i < 4; ++i) { const int row = 8 * i + (lane >> 3), c16 = lane & 7; const u32x4 v = *(const LAS u32x4*)(slab + row * 144 + c16 * 16); emit(row, 64 * h + 8 * c16, v); }
    }
}
__device__ __forceinline__ u32x4 mul_bf16x8(u32x4 a, u32x4 b) {
    u32x4 w; w.x = cvt_pk_bf16(bflo(a.x) * bflo(b.x), bfhi(a.x) * bfhi(b.x)); w.y = cvt_pk_bf16(bflo(a.y) * bflo(b.y), bfhi(a.y) * bfhi(b.y));
    w.z = cvt_pk_bf16(bflo(a.z) * bflo(b.z), bfhi(a.z) * bfhi(b.z)); w.w = cvt_pk_bf16(bflo(a.w) * bflo(b.w), bfhi(a.w) * bfhi(b.w)); return w;
}
}

__device__ __forceinline__ void seq_of_row(int row, int& seq0, int& pos, int& S) {
    if (row < M_PROMPT) { S = 4096; pos = row & 4095; } else { S = 8192; pos = row & 8191; }
    seq0 = row - pos;
}

struct Args { const float* in[12]; float* out; unsigned char* ws; };
__global__ void __launch_bounds__(NWAVES * 64, 2) fwd_kernel(Args args) {
    extern __shared__ __attribute__((aligned(16))) unsigned char lds_raw[];
    LAS unsigned char* lds = (LAS unsigned char*)lds_raw;
    volatile LAS unsigned* MISC = (volatile LAS unsigned*)(lds + MISC_OFF);
    const int tid = threadIdx.x, lane = tid & 63, wave = __builtin_amdgcn_readfirstlane(tid >> 6);
    const int G = gridDim.x, bx = blockIdx.x, vcu = (G % 8 == 0) ? (bx % 8) * (G / 8) + bx / 8 : bx;
    unsigned char* ws = args.ws; unsigned char* dout = (unsigned char*)args.out;
    unsigned* ctl = (unsigned*)(ws + WS_CTL);
    const float* x_prompt = args.in[0]; const float* x_sample = args.in[1]; const float* mem_prompt = args.in[2]; const float* mem_sample = args.in[3];
    const float* g_norm = args.in[4]; const float* w_in = args.in[5]; const float* attn_sink = args.in[6]; const float* g_mem = args.in[7];
    const float* w_mem_kv = args.in[8]; const float* w_branch = args.in[9]; const float* w_out = args.in[10]; const float* g_final = args.in[11];
    f32x2* ROPE = (f32x2*)(ws + WS_ROPE); bf16_t* MKV = (bf16_t*)(ws + WS_MKV);
    bf16_t* WBT_A = (bf16_t*)(ws + WS_WBT_A); bf16_t* WBT_B = (bf16_t*)(ws + WS_WBT_B); bf16_t* WBT_M = (bf16_t*)(ws + WS_WBT_M);
    bf16_t* WOT = (bf16_t*)(ws + WS_WOT); bf16_t* WINT = (bf16_t*)(ws + WS_WINT); bf16_t* U = (bf16_t*)(ws + WS_U); bf16_t* P = (bf16_t*)(ws + WS_P);
    bf16_t* H = (bf16_t*)(dout + DO_H); bf16_t* AZA = (bf16_t*)(dout + DO_AZA); bf16_t* AZB = AZA + 1024; bf16_t* AZM = AZA + 3072;     bf16_t* OG = (bf16_t*)(dout + DO_OG); float* LSE = (float*)(dout + DO_LSE);

    for (int u = tid; u < (LDS_BYTES - LDSCTL_OFF) / 4; u += NWAVES * 64) ((LAS unsigned*)(lds + LDSCTL_OFF))[u] = 0u;
    __syncthreads();
    XcdBarrier bar = xcd_barrier_post(ctl + CW_BAR, MISC + 8);
    const int gw = vcu * NWAVES + wave, NGW = G * NWAVES;

    {
        LAS float* scr = (LAS float*)(lds + wave * 16384);
        constexpr int I_IN = 64 * (N_IN / 32), I_KV = 64 * (N_KV / 32), I_BR = 64 * (DM / 32), I_OUT = 64 * (DM / 32);
        constexpr int NITEMS = I_IN + I_KV + I_BR + I_OUT;
        for (int it = gw; it < NITEMS; it += NGW) {
            int r = it;
            if (r < I_IN) { const int nb = r % (N_IN / 32), kb = r / (N_IN / 32); transpose_item(w_in, N_IN, 64 * kb, 32 * nb, WINT, DM, 64 * kb, 2, scr, lane); continue; } r -= I_IN;
            if (r < I_KV) { const int nb = r % (N_KV / 32), kb = r / (N_KV / 32); transpose_item(w_mem_kv, N_KV, 64 * kb, 32 * nb, WINT + (size_t)N_IN * DM, DM, 64 * kb, 1, scr, lane); continue; } r -= I_KV;
            if (r < I_BR) { const int nb = r % (DM / 32), kb = r / (DM / 32); const int k0 = 64 * kb;
                transpose_item(w_branch, DM, k0, 32 * nb, WBT_A, DM, k0, 1, scr, lane);
                continue; } r -= I_BR;
            { const int nb = r % (DM / 32), kb = r / (DM / 32); transpose_item(w_out, DM, 64 * kb, 32 * nb, WOT, DM, 64 * kb, 0, scr, lane); }
        }
        for (int m = gw; m < M_ALL; m += NGW) {
            const float* xr; const float* gn = g_norm;
            if (m < M_PROMPT) xr = x_prompt + (size_t)m * DM; else if (m < M_TOK) xr = x_sample + (size_t)(m - M_PROMPT) * DM;
            else if (m < M_TOK + 512) { xr = mem_prompt + (size_t)(m - M_TOK) * DM; gn = g_mem; } else { xr = mem_sample + (size_t)(m - M_TOK - 512) * DM; gn = g_mem; }
            rms_row_to_bf16(xr, gn, H + (size_t)m * DM, lane);
        }
        for (int e = (bx * NWAVES * 64 + tid); e < 8192 * 64; e += G * NWAVES * 64) {
            const int pos = e >> 6, i = e & 63;
            const float inv_freq = (float)pow(10000.0, -(double)(2 * i) / 128.0);
            const float ang = (float)pos * inv_freq;
            f32x2 cs; cs[0] = (float)cos((double)ang); cs[1] = (float)sin((double)ang); ROPE[e] = cs;
        }
    }
    xcd_barrier(bar);

    {
        pg8::Gemm g{H, WINT, DM, DM, DM}; pg8::StaticOrder S; S.init(M_TOK / 256, N_IN / 256, G, bx); S.extra = 32; S.xm0 = 96; S.xn0 = 116; S.xw = 8;
        EpiProj E{P, MKV, (const f32x4*)ROPE};
        pg8::gemm_phase<EpiProj>(lds, g, S, E);
    }
    xcd_barrier(bar);


#if SELFCHECK
    {
        const unsigned gt = (unsigned)bx * 512u + (unsigned)tid; const unsigned hsh = hash32(gt * 2654435761u + 12345u);
        const int row = (int)(hsh % (unsigned)M_TOK); const int col = (int)(hash32(hsh + 77u) % (unsigned)N_IN);
        const int ty = tile_type(col >> 8); float sa, ref; const bf16_t* hrow = H + (size_t)row * DM;
        if (ty == 1) { const int d = col & 127, dl = d & 63, c1 = (col & ~127) + dl, c2 = c1 + 64; float sa2;
            const float x1 = dot_bf16(hrow, WINT + (size_t)win_dest_row(c1) * DM, DM, sa), x2 = dot_bf16(hrow, WINT + (size_t)win_dest_row(c2) * DM, DM, sa2); sa += sa2;
            const int pos = row < M_PROMPT ? (row & 4095) : (row & 8191); const f32x2 cs = ROPE[pos * 64 + dl];
            ref = d < 64 ? x1 * cs[0] - x2 * cs[1] : x2 * cs[0] + x1 * cs[1]; }
        else { const float a = dot_bf16(hrow, WINT + (size_t)win_dest_row(col) * DM, DM, sa); ref = ty == 2 ? a / (1.f + expf(-a)) : (ty == 3 ? 1.f / (1.f + expf(-a)) : a); }
        const float got = bf1(P + (size_t)row * N_IN + col);
        if (!(fabsf(got - ref) <= 0.01f * fabsf(ref) + 2e-4f * sa + 1e-3f)) atomicAdd(ctl + 16, 1u);
        if (gt < 65536u) { const int mr = (int)(hsh % 1024u), mc = (int)(hash32(hsh + 99u) % 2048u);
            const float a = dot_bf16(H + (size_t)(M_TOK + mr) * DM, WINT + (size_t)(N_IN + perm_std(mc)) * DM, DM, sa); const float g2 = bf1(MKV + (size_t)mr * N_KV + mc);
            if (!(fabsf(g2 - a) <= 0.01f * fabsf(a) + 2e-4f * sa + 1e-3f)) atomicAdd(ctl + 17, 1u); }

        {
            const int hr = (int)(hash32(hsh + 1234u) % (unsigned)M_ALL), hc = (int)(hash32(hsh + 4321u) % (unsigned)DM);
            const float* xr; const float* gn = g_norm;
            if (hr < M_PROMPT) xr = x_prompt + (size_t)hr * DM; else if (hr < M_TOK) xr = x_sample + (size_t)(hr - M_PROMPT) * DM;
            else if (hr < M_TOK + 512) { xr = mem_prompt + (size_t)(hr - M_TOK) * DM; gn = g_mem; } else { xr = mem_sample + (size_t)(hr - M_TOK - 512) * DM; gn = g_mem; }
            double ss = 0.0; for (int k = 0; k < DM; ++k) ss += (double)xr[k] * (double)xr[k];
            const double hv = (double)xr[hc] / sqrt(ss / DM + 1e-6) * (double)gn[hc]; const float gh = bf1(H + (size_t)hr * DM + hc);
            if (!(fabs((double)gh - hv) <= 0.005 * fabs(hv) + 1e-6)) atomicAdd(ctl + 23, 1u);
            const int wk = (int)(hash32(hsh + 555u) % (unsigned)DM), wn = (int)(hash32(hsh + 666u) % (unsigned)N_IN);
            const float wv = w_in[(size_t)wk * N_IN + wn]; const float gwv = bf1(WINT + (size_t)win_dest_row(wn) * DM + wk);
            if (!(fabsf(gwv - wv) <= 0.005f * fabsf(wv) + 1e-9f)) atomicAdd(ctl + 24, 1u);
            const int kk = (int)(hash32(hsh + 777u) % (unsigned)DM), kn = (int)(hash32(hsh + 888u) % (unsigned)N_KV);
            const float wv2 = w_mem_kv[(size_t)kk * N_KV + kn]; const float gw2 = bf1(WINT + (size_t)(N_IN + perm_std(kn)) * DM + kk);
            if (!(fabsf(gw2 - wv2) <= 0.005f * fabsf(wv2) + 1e-9f)) atomicAdd(ctl + 24, 1u);
            const int bk = (int)(hash32(hsh + 999u) % (unsigned)DM), bn = (int)(hash32(hsh + 1111u) % (unsigned)DM);
            const float wb = w_branch[(size_t)bk * DM + bn]; const int pcn = perm_std(bn);
            const float gwb = bf1(WBT_A + (size_t)pcn * DM + bk);
            if (!(fabsf(gwb - wb) <= 0.005f * fabsf(wb) + 1e-9f)) atomicAdd(ctl + 24, 1u);
            const float wo = w_out[(size_t)bk * DM + bn]; const float gwo = bf1(WOT + (size_t)bn * DM + bk);
            if (!(fabsf(gwo - wo) <= 0.005f * fabsf(wo) + 1e-9f)) atomicAdd(ctl + 24, 1u);
        }
    }
    xcd_barrier(bar);
#endif

    {
        constexpr float L2E = 1.4426950408889634f, SC128 = 0.08838834764831845f, SC256 = 0.0625f;
        constexpr int NU_B = (M_TOK / 64) * 4, NU_A = 3 * (M_TOK / 256) * 8, NU_M = (M_TOK / 256) * 8, NU = NU_B + NU_A + NU_M;
        const int r32 = lane & 31, hi = lane >> 5;
        for (int u = bx; u < NU_B; u += G) {
            att::f32x16 o[4];
#pragma unroll
            for (int d = 0; d < 4; ++d)
#pragma unroll
                for (int r = 0; r < 16; ++r) o[d][r] = 0.f;
            float m_reg = -1e30f, l_reg = 0.f;
            {
                const int blk = u >> 2, hk = u & 3; int seq0, pos0, S; seq_of_row(blk * 64, seq0, pos0, S);
                const int hq = hk * 4 + (wave >> 1), jw = pos0 + 32 * (wave & 1);
                int klo = pos0 - 128; if (klo < 0) klo = 0; int khi = pos0 + 192; if (khi > S) khi = S;
                const float C = SC128 * L2E;
                att::attn_unit<128, 128>(lds, tid, wave, lane, P + (size_t)(seq0 + jw + r32) * N_IN + C_BQ + hq * 128 + 8 * hi,
                                         P + (size_t)seq0 * N_IN + C_BK + hk * 128, P + (size_t)seq0 * N_IN + C_BV + hk * 128, (size_t)N_IN, klo, (khi - klo) >> 6, jw, C, 8.f / SC128, o, m_reg, l_reg);
                l_reg += __builtin_amdgcn_exp2f(attn_sink[hq] * L2E - m_reg * C);
                { const bf16_t* zb = P + (size_t)(seq0 + jw) * N_IN + C_ZB + hq * 128; bf16_t* ob = AZB + (size_t)(seq0 + jw) * DM + hq * 128;
                  att::emit_rows(lds + (((khi - klo) >> 6) & 1) * att::BUF_BYTES + wave * 4608, lane, o, __builtin_amdgcn_rcpf(l_reg),
                                 [&](int row, int col, u32x4 v) { const u32x4 zz = *(const u32x4*)(zb + (size_t)row * N_IN + col); *(u32x4*)(ob + (size_t)row * DM + col) = att::mul_bf16x8(v, zz); }); }
            }
        }
        for (int u = NU_B + bx; u < NU_B + NU_A; u += G) {
            att::f32x16 o[4];
#pragma unroll
            for (int d = 0; d < 4; ++d)
#pragma unroll
                for (int r = 0; r < 16; ++r) o[d][r] = 0.f;
            float m_reg = -1e30f, l_reg = 0.f;
            {
                const int v = u - NU_B, g = v / ((M_TOK / 256) * 8), rem = v % ((M_TOK / 256) * 8), head = rem & 7, blk = rem >> 3;
                const int dl = g == 0 ? 1 : (g == 1 ? 4 : 16); int seq0, pos0, S; seq_of_row(blk * 256, seq0, pos0, S);
                const int ui = pos0 >> 8, res = ui % dl, j0 = (ui / dl) * 256, SD = S / dl, jw = j0 + 32 * wave;
                int klo = j0 - 64; if (klo < 0) klo = 0; int khi = j0 + 320; if (khi > SD) khi = SD;
                const int hc = g * 1024 + head * 128; const float C = SC128 * L2E;
                att::attn_unit<128, 64>(lds, tid, wave, lane, P + (size_t)(seq0 + (jw + r32) * dl + res) * N_IN + C_AQ + hc + 8 * hi,
                                        P + (size_t)(seq0 + res) * N_IN + C_AK + hc, P + (size_t)(seq0 + res) * N_IN + C_AV + hc, (size_t)dl * N_IN, klo, (khi - klo) >> 6, jw, C, 8.f / SC128, o, m_reg, l_reg);
                { bf16_t* ob = OG + ((size_t)g * M_TOK + (size_t)(seq0 + jw * dl + res)) * 1024 + head * 128;
                  att::emit_rows(lds + (((khi - klo) >> 6) & 1) * att::BUF_BYTES + wave * 4608, lane, o, __builtin_amdgcn_rcpf(l_reg),
                                 [&](int row, int col, u32x4 v) { *(u32x4*)(ob + (size_t)row * dl * 1024 + col) = v; }); }
                if (hi == 0) LSE[((size_t)g * M_TOK + (size_t)(seq0 + (jw + r32) * dl + res)) * 8 + head] = m_reg * SC128 + __logf(l_reg);
            }
        }
        for (int u = NU_B + NU_A + bx; u < NU; u += G) {
            att::f32x16 o[4];
#pragma unroll
            for (int d = 0; d < 4; ++d)
#pragma unroll
                for (int r = 0; r < 16; ++r) o[d][r] = 0.f;
            float m_reg = -1e30f, l_reg = 0.f;
            {
                const int v = u - NU_B - NU_A, half = v & 1, hm = (v >> 1) & 3, blk = v >> 3; const int row0 = blk * 256;
                const int seq = row0 < M_PROMPT ? (row0 >> 12) : 2 + ((row0 - M_PROMPT) >> 13); const int jw = 32 * wave; const float C = SC256 * L2E;
                const bf16_t* kb = MKV + (size_t)(seq * 256) * N_KV + hm * 256;
                att::attn_unit<256, 0>(lds, tid, wave, lane, P + (size_t)(row0 + jw + r32) * N_IN + C_MQ + hm * 256 + 8 * hi, kb, kb + 1024 + half * 128, (size_t)N_KV, 0, 4, jw, C, 8.f / SC256, o, m_reg, l_reg);
                { const bf16_t* zb = P + (size_t)(row0 + jw) * N_IN + C_ZM + hm * 256 + half * 128; bf16_t* ob = AZM + (size_t)(row0 + jw) * DM + hm * 256 + half * 128;
                  att::emit_rows(lds + 0 * att::BUF_BYTES + wave * 4608, lane, o, __builtin_amdgcn_rcpf(l_reg),
                                 [&](int row, int col, u32x4 v) { const u32x4 zz = *(const u32x4*)(zb + (size_t)row * N_IN + col); *(u32x4*)(ob + (size_t)row * DM + col) = att::mul_bf16x8(v, zz); }); }
            }
        }
    }
    xcd_barrier(bar);
    {
        struct RowIn { u32x4 g0[2], g1[2], g2[2], zz[2]; float l0[2], l1[2], l2[2]; };
        auto load_row = [&](int m, RowIn& r) {
#pragma unroll
            for (int hh = 0; hh < 2; ++hh) { const int c0 = hh * 512 + lane * 8, head = hh * 4 + (lane >> 4);
                r.g0[hh] = *(const u32x4*)(OG + ((size_t)0 * M_TOK + m) * 1024 + c0); r.g1[hh] = *(const u32x4*)(OG + ((size_t)1 * M_TOK + m) * 1024 + c0); r.g2[hh] = *(const u32x4*)(OG + ((size_t)2 * M_TOK + m) * 1024 + c0);
                r.zz[hh] = *(const u32x4*)(P + (size_t)m * N_IN + C_ZA + c0);
                r.l0[hh] = LSE[((size_t)0 * M_TOK + m) * 8 + head]; r.l1[hh] = LSE[((size_t)1 * M_TOK + m) * 8 + head]; r.l2[hh] = LSE[((size_t)2 * M_TOK + m) * 8 + head]; }
        };
        auto emit_row = [&](int m, const RowIn& r) {
#pragma unroll
            for (int hh = 0; hh < 2; ++hh) { const int c0 = hh * 512 + lane * 8;
                const float mx = fmaxf(r.l0[hh], fmaxf(r.l1[hh], r.l2[hh])); float a0 = __expf(r.l0[hh] - mx), a1 = __expf(r.l1[hh] - mx), a2 = __expf(r.l2[hh] - mx); const float inv = 1.0f / (a0 + a1 + a2); a0 *= inv; a1 *= inv; a2 *= inv;
                u32x4 w;
#define CMB(f) cvt_pk_bf16((a0 * bflo(r.g0[hh].f) + a1 * bflo(r.g1[hh].f) + a2 * bflo(r.g2[hh].f)) * bflo(r.zz[hh].f), (a0 * bfhi(r.g0[hh].f) + a1 * bfhi(r.g1[hh].f) + a2 * bfhi(r.g2[hh].f)) * bfhi(r.zz[hh].f))
                w.x = CMB(x); w.y = CMB(y); w.z = CMB(z); w.w = CMB(w);
#undef CMB
                *(u32x4*)(AZA + (size_t)m * DM + c0) = w; }
        };
        int m = gw;
        for (; m + NGW < M_TOK; m += 2 * NGW) { RowIn ra, rb; load_row(m, ra); load_row(m + NGW, rb); emit_row(m, ra); emit_row(m + NGW, rb); }
        if (m < M_TOK) { RowIn ra; load_row(m, ra); emit_row(m, ra); }
    }
    xcd_barrier(bar);

#if SELFCHECK
    {
        const unsigned gt = (unsigned)bx * 512u + (unsigned)tid; const unsigned hsh = hash32(gt * 2654435761u + 31337u);
        const int row = (int)(hsh % (unsigned)M_TOK); int seq0, pos, S; seq_of_row(row, seq0, pos, S);
        const int which = (int)(gt % 3u);
        if (which == 0) {
            const int hs = (int)(hash32(hsh + 1u) % 8u), d = (int)(hash32(hsh + 2u) % 128u);
            double mx = -1e300, den = 0.0, acc = 0.0;
            for (int pass = 0; pass < 2; ++pass)
                for (int gi = 0; gi < 3; ++gi) { const int dd = gi == 0 ? 1 : (gi == 1 ? 4 : 16); const int tlo = min(64, pos / dd), thi = min(64, (S - 1 - pos) / dd); const int hc = gi * 1024 + hs * 128;
                    const bf16_t* qp = P + (size_t)row * N_IN + C_AQ + hc;
                    for (int t = -tlo; t <= thi; ++t) { const bf16_t* kp = P + (size_t)(row + t * dd) * N_IN + C_AK + hc; double sdot = 0.0;
                        for (int k = 0; k < 128; ++k) sdot += (double)bf1(qp + k) * (double)bf1(kp + k);
                        sdot *= 0.08838834764831845;
                        if (pass == 0) mx = sdot > mx ? sdot : mx; else { const double e = exp(sdot - mx); den += e; acc += e * (double)bf1(P + (size_t)(row + t * dd) * N_IN + C_AV + hc + d); } } }
            const double ref = acc / den * (double)bf1(P + (size_t)row * N_IN + C_ZA + hs * 128 + d); const double got = (double)bf1(AZA + (size_t)row * DM + hs * 128 + d);
            if (!(fabs(got - ref) <= 0.02 * fabs(ref) + 4e-4)) atomicAdd(ctl + 20, 1u);
        } else if (which == 1) {
            const int hq = (int)(hash32(hsh + 1u) % 16u), hk = hq >> 2, d = (int)(hash32(hsh + 2u) % 128u);
            const double sk = (double)attn_sink[hq]; double mx = sk, den = 0.0, acc = 0.0; const int tlo = min(128, pos), thi = min(128, S - 1 - pos);
            const bf16_t* qp = P + (size_t)row * N_IN + C_BQ + hq * 128;
            for (int pass = 0; pass < 2; ++pass)
                for (int t = -tlo; t <= thi; ++t) { const bf16_t* kp = P + (size_t)(row + t) * N_IN + C_BK + hk * 128; double sdot = 0.0;
                    for (int k = 0; k < 128; ++k) sdot += (double)bf1(qp + k) * (double)bf1(kp + k);
                    sdot *= 0.08838834764831845;
                    if (pass == 0) mx = sdot > mx ? sdot : mx; else { const double e = exp(sdot - mx); den += e; acc += e * (double)bf1(P + (size_t)(row + t) * N_IN + C_BV + hk * 128 + d); } }
            den += exp(sk - mx);
            const double ref = acc / den * (double)bf1(P + (size_t)row * N_IN + C_ZB + hq * 128 + d); const double got = (double)bf1(AZB + (size_t)row * DM + hq * 128 + d);
            if (!(fabs(got - ref) <= 0.02 * fabs(ref) + 4e-4)) atomicAdd(ctl + 21, 1u);
        } else {
            const int hm = (int)(hash32(hsh + 1u) % 4u), d = (int)(hash32(hsh + 2u) % 256u); const int seq = row < M_PROMPT ? (row >> 12) : 2 + ((row - M_PROMPT) >> 13);
            double mx = -1e300, den = 0.0, acc = 0.0; const bf16_t* qp = P + (size_t)row * N_IN + C_MQ + hm * 256;
            for (int pass = 0; pass < 2; ++pass)
                for (int j = 0; j < 256; ++j) { const bf16_t* kp = MKV + (size_t)(seq * 256 + j) * N_KV + hm * 256; double sdot = 0.0;
                    for (int k = 0; k < 256; ++k) sdot += (double)bf1(qp + k) * (double)bf1(kp + k);
                    sdot *= 0.0625;
                    if (pass == 0) mx = sdot > mx ? sdot : mx; else { const double e = exp(sdot - mx); den += e; acc += e * (double)bf1(kp + 1024 + d); } }
            const double ref = acc / den * (double)bf1(P + (size_t)row * N_IN + C_ZM + hm * 256 + d); const double got = (double)bf1(AZM + (size_t)row * DM + hm * 256 + d);
            if (!(fabs(got - ref) <= 0.02 * fabs(ref) + 4e-4)) atomicAdd(ctl + 22, 1u);
        }
    }
    xcd_barrier(bar);
#endif

    {
        pg8::StaticOrder S; S.init(M_TOK / 256, DM / 256, G, bx);
        { pg8::Gemm g{AZA, WBT_A, DM, DM, DM}; EpiBranchFused E{P, U}; pg8::gemm_phase<EpiBranchFused>(lds, g, S, E); }
    }
    xcd_barrier(bar);


#if SELFCHECK
    {
        const unsigned gt = (unsigned)bx * 512u + (unsigned)tid; const unsigned hsh = hash32(gt * 2654435761u + 999u);
        const int row = (int)(hsh % (unsigned)M_TOK); const int col = (int)(hash32(hsh + 7u) % (unsigned)DM); const int pc = perm_std(col);
        float sa, sb, sm;
        const float ta = dot_bf16(AZA + (size_t)row * DM, WBT_A + (size_t)pc * DM, 1024, sa);
        const float tb = dot_bf16(AZB + (size_t)row * DM, WBT_A + (size_t)pc * DM + 1024, 2048, sb);
        const float tm = dot_bf16(AZM + (size_t)row * DM, WBT_A + (size_t)pc * DM + 3072, 1024, sm);
        const float ga = bf1(P + (size_t)row * N_IN + C_GA + col), gb = bf1(P + (size_t)row * N_IN + C_GB + col), gm = bf1(P + (size_t)row * N_IN + C_GM + col);
        float u = rbf(ga * ta); u = rbf(u + gb * tb); u = rbf(u + gm * tm);
        const float got = bf1(U + (size_t)row * DM + col);
        if (!(fabsf(got - u) <= 0.02f * fabsf(u) + 2e-4f * (sa + sb + sm) + 1e-5f)) atomicAdd(ctl + 18, 1u);
    }
    xcd_barrier(bar);
#endif

    {
        pg8::StaticOrder S; S.init(M_TOK / 256, DM / 256, G, bx);
        pg8::Gemm g{U, WOT, DM, DM, DM}; EpiOut E{x_prompt, x_sample, args.out};
        pg8::gemm_phase<EpiOut>(lds, g, S, E);
    }
    xcd_barrier(bar);


#if SELFCHECK
    {
        const unsigned gt = (unsigned)bx * 512u + (unsigned)tid; const unsigned hsh = hash32(gt * 2654435761u + 4242u);
        const int row = (int)(hsh % (unsigned)M_TOK); const int col = (int)(hash32(hsh + 5u) % (unsigned)DM); float sa;
        const float t = dot_bf16(U + (size_t)row * DM, WOT + (size_t)col * DM, DM, sa);
        const float xv = row < M_PROMPT ? x_prompt[(size_t)row * DM + col] : x_sample[(size_t)(row - M_PROMPT) * DM + col];
        const float got = args.out[(size_t)row * DM + col];
        if (!(fabsf(got - (xv + t)) <= 1e-4f * sa + 1e-5f)) atomicAdd(ctl + 19, 1u);
    }
    xcd_barrier(bar);
#endif

    {
        const unsigned bad = __hip_atomic_load(ctl + CW_BAR + XB_TMO, __ATOMIC_RELAXED, __HIP_MEMORY_SCOPE_AGENT);
        for (int m = gw; m < M_TOK; m += NGW) {
            f32x4* xr = (f32x4*)(args.out + (size_t)m * DM) + lane; f32x4 v[16]; float s = 0.f;
#pragma unroll
            for (int j = 0; j < 16; ++j) { v[j] = xr[64 * j]; s += (v[j][0] * v[j][0] + v[j][1] * v[j][1]) + (v[j][2] * v[j][2] + v[j][3] * v[j][3]); }
            float rstd = 1.0f / sqrtf(wave_sum(s) * (1.0f / DM) + NORM_EPS);
            if (bad) rstd = __builtin_nanf("");
#if SELFCHECK
            { const unsigned f1 = __hip_atomic_load(ctl + 16, __ATOMIC_RELAXED, __HIP_MEMORY_SCOPE_AGENT), f2 = __hip_atomic_load(ctl + 17, __ATOMIC_RELAXED, __HIP_MEMORY_SCOPE_AGENT), f3 = __hip_atomic_load(ctl + 18, __ATOMIC_RELAXED, __HIP_MEMORY_SCOPE_AGENT), f4 = __hip_atomic_load(ctl + 19, __ATOMIC_RELAXED, __HIP_MEMORY_SCOPE_AGENT);
              const unsigned a0 = __hip_atomic_load(ctl + 20, __ATOMIC_RELAXED, __HIP_MEMORY_SCOPE_AGENT), a1 = __hip_atomic_load(ctl + 21, __ATOMIC_RELAXED, __HIP_MEMORY_SCOPE_AGENT), a2 = __hip_atomic_load(ctl + 22, __ATOMIC_RELAXED, __HIP_MEMORY_SCOPE_AGENT), a3 = __hip_atomic_load(ctl + 23, __ATOMIC_RELAXED, __HIP_MEMORY_SCOPE_AGENT), a4 = __hip_atomic_load(ctl + 24, __ATOMIC_RELAXED, __HIP_MEMORY_SCOPE_AGENT);
              rstd *= 1.0f + (a0 > 100u ? 0.1f : 0.f) + (a1 > 100u ? 0.2f : 0.f) + (a2 > 100u ? 0.4f : 0.f) + (a3 ? 0.8f : 0.f) + (a4 ? 1.6f : 0.f) + ((f1 | f2 | f3 | f4) ? 3.2f : 0.f); }
#endif
            const f32x4* gr = (const f32x4*)g_final + lane;
#pragma unroll
            for (int j = 0; j < 16; ++j) { const f32x4 g = gr[64 * j]; xr[64 * j] = v[j] * rstd * g; }
        }
    }
}

extern "C" void kernel_launch(void* const* d_in, const int* in_sizes, int n_in, void* d_out, int out_size, void* d_ws, size_t ws_size, hipStream_t stream) {
    static int grid = 0;
    if (grid == 0) {
        if (n_in != 12 || out_size != M_TOK * DM || ws_size < WS_END) { fprintf(stderr, "kernel_launch: unexpected shapes (n_in %d, out %d, ws %zu)\n", n_in, out_size, ws_size); grid = -1; return; }
        int dev = 0, cus = 0, per_cu = 0;
        if (hipGetDevice(&dev) != hipSuccess || hipDeviceGetAttribute(&cus, hipDeviceAttributeMultiprocessorCount, dev) != hipSuccess) { grid = -1; return; }
        if (hipFuncSetAttribute((const void*)fwd_kernel, hipFuncAttributeMaxDynamicSharedMemorySize, LDS_BYTES) != hipSuccess) { fprintf(stderr, "kernel_launch: hipFuncSetAttribute failed\n"); grid = -1; return; }
        if (hipOccupancyMaxActiveBlocksPerMultiprocessor(&per_cu, (const void*)fwd_kernel, NWAVES * 64, LDS_BYTES) != hipSuccess || per_cu < 1) { fprintf(stderr, "kernel_launch: occupancy query says %d\n", per_cu); (void)hipGetLastError(); if (per_cu < 1) { grid = -1; return; } }
        grid = cus;
    }
    if (grid < 0) return;
    if (hipMemsetAsync((char*)d_ws + WS_CTL, 0, CTL_ZERO_BYTES, stream) != hipSuccess) return;
    Args a{};
    for (int i = 0; i < 12; ++i) a.in[i] = (const float*)d_in[i];
    a.out = (float*)d_out; a.ws = (unsigned char*)d_ws;
    hipLaunchKernelGGL(fwd_kernel, dim3(grid), dim3(NWAVES * 64), LDS_BYTES, stream, a);
}
```

```cpp
#include <hip/hip_runtime.h>
#include <cstdio>
#include <cstdint>

#define GAS __attribute__((address_space(1)))
#define LAS __attribute__((address_space(3)))
typedef unsigned short bf16_t;
typedef short bf16x8 __attribute__((ext_vector_type(8)));
typedef float f32x4 __attribute__((ext_vector_type(4)));
typedef float f32x2 __attribute__((ext_vector_type(2)));
typedef unsigned u32x4 __attribute__((ext_vector_type(4)));
typedef unsigned u32x2 __attribute__((ext_vector_type(2)));

constexpr int DM = 4096;
constexpr int M_PROMPT = 8192, M_TOK = 24576, M_MEM = 1024, M_ALL = M_TOK + M_MEM;
constexpr int N_IN = 29696, N_KV = 2048, N_ALL = N_IN + N_KV;
constexpr int C_AQ = 0, C_AK = 3072, C_AV = 6144, C_BQ = 9216, C_BK = 11264, C_BV = 11776, C_MQ = 12288, C_ZA = 13312, C_ZB = 14336, C_ZM = 16384, C_GA = 17408, C_GB = 21504, C_GM = 25600;
constexpr float NORM_EPS = 1e-6f;
constexpr int NWAVES = 8;

constexpr size_t MiB = 1u << 20;
constexpr size_t WS_CTL = 0, CTL_ZERO_BYTES = 1 * MiB;
constexpr size_t WS_ROPE = 1 * MiB;
constexpr size_t WS_MKV = 5 * MiB;
constexpr size_t WS_WBT_A = 9 * MiB, WS_WBT_B = 17 * MiB, WS_WBT_M = 33 * MiB;
constexpr size_t WS_WOT = 41 * MiB;
constexpr size_t WS_WINT = 73 * MiB;
constexpr size_t WS_U = WS_WINT;
constexpr size_t WS_P = 321 * MiB;
constexpr size_t WS_END = 1713 * MiB;
constexpr size_t DO_H = 0, DO_AZA = 0, DO_AZB = 48 * MiB, DO_AZM = 144 * MiB, DO_OG = 192 * MiB, DO_LSE = 336 * MiB;
constexpr int CW_BAR = 4096;

constexpr int RING_BYTES = 131072;
constexpr int LDSCTL_OFF = RING_BYTES, MISC_OFF = LDSCTL_OFF + 320;
constexpr int LDS_BYTES = 147456;

__device__ __forceinline__ int lane_now() { int l; asm volatile("v_mbcnt_lo_u32_b32 %0, -1, 0\n\tv_mbcnt_hi_u32_b32 %0, -1, %0" : "=v"(l)); return l; }
__device__ __forceinline__ unsigned cvt_pk_bf16(float lo, float hi) { unsigned r; asm volatile("v_cvt_pk_bf16_f32 %0, %1, %2" : "=v"(r) : "v"(lo), "v"(hi)); return r; }
__device__ __forceinline__ float bflo(unsigned w) { return __uint_as_float(w << 16); }
__device__ __forceinline__ float bfhi(unsigned w) { return __uint_as_float(w & 0xffff0000u); }
__device__ __forceinline__ float sigmoidf_(float x) { return __builtin_amdgcn_rcpf(1.0f + __expf(-x)); }

namespace pg8 {
constexpr int BM = 256, BK = 64, HALF = 128, HTB = HALF * BK * 2, STAGE_BYTES = 8 * HTB, NXCD = 8, WGM = 8;
__host__ __device__ __forceinline__ int lds_byte(int r, int c) { const int st = (r >> 4) * 2 + (c >> 5), rr = r & 15, cc = c & 31, ob = rr * 64 + cc * 2; return st * 1024 + (ob ^ (((ob >> 9) & 1) << 5)); }
__host__ __device__ __forceinline__ void stage_rc(int b, int& R, int& C) { const int st = b / 1024, sb = b % 1024, swz = sb ^ (((sb >> 9) & 1) << 5); R = (st >> 1) * 16 + swz / 64; C = (st & 1) * 32 + (swz % 64) / 2; }

struct Unit { int pm, pn; };
struct Gemm { const bf16_t* A; const bf16_t* Bt; int lda, ldb, K; };

struct StaticOrder {
    int nM, nN, nwg, G, c, extra, xm0, xn0, xw;
    __device__ void init(int nM_, int nN_, int G_, int c_) { nM = nM_; nN = nN_; nwg = nM * nN; G = G_; c = c_; extra = 0; xm0 = 0; xn0 = 0; xw = 1; }
    __device__ bool next(int i, Unit& u) const {
        const long L = (long)i * G + c;
        if (L >= nwg) { const int j = (int)(L - nwg); if (j >= extra) return false; u.pm = xm0 + j / xw; u.pn = xn0 + j % xw; return true; }
        int wgid = (int)L; { const int q = nwg / NXCD, r = nwg % NXCD, xcd = wgid % NXCD, off = wgid / NXCD; wgid = (xcd < r ? xcd * (q + 1) : r * (q + 1) + (xcd - r) * q) + off; }
        const int nig = WGM * nN, gid = wgid / nig, fm = gid * WGM, gsz = (nM - fm) < WGM ? (nM - fm) : WGM;
        u.pm = fm + ((wgid % nig) % gsz); u.pn = (wgid % nig) / gsz; return true;
    }
};

template <class Epi, bool ALIGN_EPI = true>
__device__ __forceinline__ void gemm_phase(LAS unsigned char* lds, const Gemm g, const StaticOrder& S, const Epi& E) {
    const int tid = threadIdx.x, wid = __builtin_amdgcn_readfirstlane(tid >> 6), lane = tid & 63, wr = wid >> 2, wc = wid & 3, fr = lane & 15, fq = lane >> 4;
    const int K = g.K, nt = K / BK;
    unsigned voffA[2], voffB[2];
#pragma unroll
    for (int i = 0; i < 2; ++i) { int R, C; stage_rc(tid * 16 + i * 8192, R, C); voffA[i] = (unsigned)(R * g.lda + C) * 2u; voffB[i] = (unsigned)(R * g.ldb + C) * 2u; }
    const size_t kstep = (size_t)(BK * 2);
    const size_t hstepA = (size_t)HALF * g.lda * 2, hstepB = (size_t)HALF * g.ldb * 2;
    const size_t tstepA = 2 * hstepA, tstepB = 2 * hstepB;
    const unsigned ldsw = (unsigned)wid * 1024u;
    const int aoff = lds_byte(wr * 64 + fr, fq * 8), boff = lds_byte(wc * 32 + fr, fq * 8);
#define PG8_SA(b, h) (((b) * 2 + (h)) * HTB)
#define PG8_SB(b, h) ((4 + (b) * 2 + (h)) * HTB)
#define PG8_STAGE(bufoff, gbase, voff) do { _Pragma("unroll") for (int _i = 0; _i < 2; ++_i) \
        __builtin_amdgcn_global_load_lds((const unsigned*)((const char*)(gbase) + (voff)[_i]), (LAS unsigned*)(lds + (bufoff) + ldsw + _i * 8192), 16, 0, 0); } while (0)
#define PG8_LDA(dst, b, h) do { _Pragma("unroll") for (int m = 0; m < 4; ++m) _Pragma("unroll") for (int k = 0; k < 2; ++k) dst[m][k] = *(const LAS bf16x8*)(lds + PG8_SA(b, h) + aoff + m * 2048 + k * 1024); } while (0)
#define PG8_LDB(dst, b, h) do { _Pragma("unroll") for (int n = 0; n < 2; ++n) _Pragma("unroll") for (int k = 0; k < 2; ++k) dst[n][k] = *(const LAS bf16x8*)(lds + PG8_SB(b, h) + boff + n * 2048 + k * 1024); } while (0)
#define PG8_MMA(ai, bj, At, Bt) do { __builtin_amdgcn_s_setprio(1); _Pragma("unroll") for (int m = 0; m < 4; ++m) _Pragma("unroll") for (int n = 0; n < 2; ++n) _Pragma("unroll") for (int k = 0; k < 2; ++k) \
        acc[ai][bj][m][n] = __builtin_amdgcn_mfma_f32_16x16x32_bf16(Bt[n][k], At[m][k], acc[ai][bj][m][n], 0, 0, 0); __builtin_amdgcn_s_setprio(0); } while (0)
#define PG8_WAIT_V(n) asm volatile("s_waitcnt vmcnt(" #n ")" ::: "memory")
#define PG8_WAIT_L(n) asm volatile("s_waitcnt lgkmcnt(" #n ")" ::: "memory")
#define PG8_BAR __builtin_amdgcn_s_barrier()
#define PG8_SCHED __builtin_amdgcn_sched_barrier(0)
    Unit cur, nxt; int ui = 0;
    if (!S.next(0, cur)) return;
    f32x4 acc[2][2][4][2];
#pragma unroll
    for (int a = 0; a < 2; ++a)
#pragma unroll
        for (int b = 0; b < 2; ++b)
#pragma unroll
            for (int m = 0; m < 4; ++m)
#pragma unroll
                for (int n = 0; n < 2; ++n) acc[a][b][m][n] = (f32x4){0.f, 0.f, 0.f, 0.f};
    bf16x8 At[4][2], B0[2][2], B1[2][2];
    const char* cA = (const char*)g.A + (size_t)cur.pm * tstepA; const char* cB = (const char*)g.Bt + (size_t)cur.pn * tstepB;
    PG8_STAGE(PG8_SB(0, 0), cB, voffB); PG8_STAGE(PG8_SB(0, 1), cB + hstepB, voffB); PG8_STAGE(PG8_SA(0, 0), cA, voffA); PG8_STAGE(PG8_SA(0, 1), cA + hstepA, voffA);
    if (wr == 1) PG8_BAR;
    PG8_WAIT_V(2); PG8_BAR;
    PG8_STAGE(PG8_SB(1, 0), cB + kstep, voffB); PG8_STAGE(PG8_SA(1, 0), cA + kstep, voffA); PG8_STAGE(PG8_SB(1, 1), cB + hstepB + kstep, voffB);
    PG8_WAIT_V(6); PG8_BAR;
    for (;;) {
        const bool has_next = S.next(ui + 1, nxt);
        const char* nA = has_next ? (const char*)g.A + (size_t)nxt.pm * tstepA : cA; const char* nB = has_next ? (const char*)g.Bt + (size_t)nxt.pn * tstepB : cB;
        for (int t = 0; t < nt; t += 2) {
            if constexpr (Epi::HAS_MID) { if (t == Epi::MID0 || t == Epi::MID1) E.mid(acc, cur, t, wr, wc); }
            const bool last = (t == nt - 2);
            const char* a1 = cA + (size_t)(t + 1) * kstep;
            const char* a2 = last ? nA : cA + (size_t)(t + 2) * kstep; const char* b2 = last ? nB : cB + (size_t)(t + 2) * kstep;
            const char* a3 = a2 + kstep; const char* b3 = b2 + kstep;
            PG8_LDB(B0, 0, 0); PG8_LDB(B1, 0, 1); PG8_SCHED; PG8_LDA(At, 0, 0); PG8_STAGE(PG8_SA(1, 1), a1 + hstepA, voffA);
            PG8_WAIT_V(8); PG8_WAIT_L(0); PG8_BAR; PG8_MMA(0, 0, At, B0); PG8_MMA(0, 1, At, B1); PG8_BAR; PG8_SCHED;
            PG8_LDA(At, 0, 1); PG8_STAGE(PG8_SB(0, 0), b2, voffB); PG8_STAGE(PG8_SB(0, 1), b2 + hstepB, voffB); PG8_STAGE(PG8_SA(0, 0), a2, voffA);
            PG8_WAIT_V(8); PG8_WAIT_L(0); PG8_BAR; PG8_MMA(1, 0, At, B0); PG8_MMA(1, 1, At, B1); PG8_BAR; PG8_SCHED;
            PG8_LDB(B0, 1, 0); PG8_LDB(B1, 1, 1); PG8_SCHED; PG8_LDA(At, 1, 0); PG8_STAGE(PG8_SA(0, 1), a2 + hstepA, voffA);
            PG8_WAIT_V(8); PG8_WAIT_L(0); PG8_BAR; PG8_MMA(0, 0, At, B0); PG8_MMA(0, 1, At, B1); PG8_BAR; PG8_SCHED;
            PG8_LDA(At, 1, 1); PG8_STAGE(PG8_SB(1, 0), b3, voffB); PG8_STAGE(PG8_SB(1, 1), b3 + hstepB, voffB); PG8_STAGE(PG8_SA(1, 0), a3, voffA);
            PG8_WAIT_V(8); PG8_WAIT_L(0); PG8_BAR; PG8_MMA(1, 0, At, B0); PG8_MMA(1, 1, At, B1); PG8_BAR; PG8_SCHED;
        }
        if constexpr (ALIGN_EPI) { if (wr == 0) PG8_BAR; }
        E(acc, cur, wr, wc, fr, fq);
        if (!has_next) break;
#pragma unroll
        for (int a = 0; a < 2; ++a)
#pragma unroll
            for (int b = 0; b < 2; ++b)
#pragma unroll
                for (int m = 0; m < 4; ++m)
#pragma unroll
                    for (int n = 0; n < 2; ++n) acc[a][b][m][n] = (f32x4){0.f, 0.f, 0.f, 0.f};
        cur = nxt; cA = nA; cB = nB; ++ui;
        if constexpr (ALIGN_EPI) { if (wr == 1) PG8_BAR; }
    }
    PG8_WAIT_V(0);
    if constexpr (!ALIGN_EPI) { if (wr == 0) PG8_BAR; }
    PG8_BAR;
#undef PG8_SA
#undef PG8_SB
#undef PG8_STAGE
#undef PG8_LDA
#undef PG8_LDB
#undef PG8_MMA
#undef PG8_WAIT_V
#undef PG8_WAIT_L
#undef PG8_BAR
#undef PG8_SCHED
}
}

__device__ __forceinline__ int tile_type(int pn) {
    if (pn < 24) return 1; if (pn < 36) return 0; if (pn < 46) return 1; if (pn < 52) return 0; if (pn < 68) return 2; if (pn < 116) return 3; return 0;
}
struct EpiProj {
    static constexpr bool HAS_MID = false; static constexpr int MID0 = -1, MID1 = -1;
    bf16_t* P; bf16_t* MKV; const f32x4* rope;
    __device__ __forceinline__ void operator()(const f32x4 (&acc)[2][2][4][2], const pg8::Unit& u, int wr, int wc, int fr, int fq) const {
        if (u.pm >= 96) {
            const int row0 = (u.pm - 96) * 256 + wr * 64 + fr, col0 = (u.pn - 116) * 256 + wc * 32 + 8 * fq;
#pragma unroll
            for (int ai = 0; ai < 2; ++ai)
#pragma unroll
                for (int m = 0; m < 4; ++m) { bf16_t* rowp = MKV + (size_t)(row0 + ai * 128 + m * 16) * N_KV + col0;
#pragma unroll
                    for (int bj = 0; bj < 2; ++bj) { const f32x4 v0 = acc[ai][bj][m][0], v1 = acc[ai][bj][m][1];
                        u32x4 w; w.x = cvt_pk_bf16(v0[0], v0[1]); w.y = cvt_pk_bf16(v0[2], v0[3]); w.z = cvt_pk_bf16(v1[0], v1[1]); w.w = cvt_pk_bf16(v1[2], v1[3]);
                        *(u32x4*)(rowp + bj * 128) = w; } }
            return;
        }
        const int ty = tile_type(u.pn);
        const int row0 = u.pm * 256 + wr * 64 + fr;
        if (ty == 1) {
#pragma unroll
            for (int ai = 0; ai < 2; ++ai)
#pragma unroll
                for (int m = 0; m < 4; ++m) {
                    const int row = row0 + ai * 128 + m * 16; const int pos = row < M_PROMPT ? (row & 4095) : (row & 8191);
                    const f32x4* t = rope + (size_t)pos * 32 + 8 * wc + 2 * fq; const f32x4 t0 = t[0], t1 = t[1];
                    bf16_t* rowp = P + (size_t)row * N_IN + u.pn * 256 + 16 * wc + 4 * fq;
#pragma unroll
                    for (int bj = 0; bj < 2; ++bj) { const f32x4 x1 = acc[ai][bj][m][0], x2 = acc[ai][bj][m][1];
                        const float l0 = x1[0] * t0[0] - x2[0] * t0[1], h0 = x2[0] * t0[0] + x1[0] * t0[1];
                        const float l1 = x1[1] * t0[2] - x2[1] * t0[3], h1 = x2[1] * t0[2] + x1[1] * t0[3];
                        const float l2 = x1[2] * t1[0] - x2[2] * t1[1], h2 = x2[2] * t1[0] + x1[2] * t1[1];
                        const float l3 = x1[3] * t1[2] - x2[3] * t1[3], h3 = x2[3] * t1[2] + x1[3] * t1[3];
                        u32x2 lo, hi; lo.x = cvt_pk_bf16(l0, l1); lo.y = cvt_pk_bf16(l2, l3); hi.x = cvt_pk_bf16(h0, h1); hi.y = cvt_pk_bf16(h2, h3);
                        *(u32x2*)(rowp + bj * 128) = lo; *(u32x2*)(rowp + bj * 128 + 64) = hi; }
                }
            return;
        }
#pragma unroll
        for (int ai = 0; ai < 2; ++ai)
#pragma unroll
            for (int m = 0; m < 4; ++m) { bf16_t* rowp = P + (size_t)(row0 + ai * 128 + m * 16) * N_IN + u.pn * 256 + wc * 32 + 8 * fq;
#pragma unroll
                for (int bj = 0; bj < 2; ++bj) { f32x4 v0 = acc[ai][bj][m][0], v1 = acc[ai][bj][m][1];
                    if (ty == 2) {
#pragma unroll
                        for (int j = 0; j < 4; ++j) { v0[j] = v0[j] * sigmoidf_(v0[j]); v1[j] = v1[j] * sigmoidf_(v1[j]); } }
                    else if (ty == 3) {
#pragma unroll
                        for (int j = 0; j < 4; ++j) { v0[j] = sigmoidf_(v0[j]); v1[j] = sigmoidf_(v1[j]); } }
                    u32x4 w; w.x = cvt_pk_bf16(v0[0], v0[1]); w.y = cvt_pk_bf16(v0[2], v0[3]); w.z = cvt_pk_bf16(v1[0], v1[1]); w.w = cvt_pk_bf16(v1[2], v1[3]);
                    *(u32x4*)(rowp + bj * 128) = w; } }
    }
};
struct EpiBranch {
    static constexpr bool HAS_MID = false; static constexpr int MID0 = -1, MID1 = -1;
    const bf16_t* G; bf16_t* U; int first;
    __device__ __forceinline__ void operator()(const f32x4 (&acc)[2][2][4][2], const pg8::Unit& u, int wr, int wc, int fr, int fq) const {
        const int row0 = u.pm * 256 + wr * 64 + fr, col0 = u.pn * 256 + wc * 32 + 8 * fq;
#pragma unroll
        for (int ai = 0; ai < 2; ++ai)
#pragma unroll
            for (int m = 0; m < 4; ++m) { const int row = row0 + ai * 128 + m * 16; const bf16_t* gp = G + (size_t)row * N_IN + col0; bf16_t* up = U + (size_t)row * DM + col0;
#pragma unroll
                for (int bj = 0; bj < 2; ++bj) { const u32x4 gw = *(const u32x4*)(gp + bj * 128); f32x4 v0 = acc[ai][bj][m][0], v1 = acc[ai][bj][m][1];
                    v0[0] *= bflo(gw.x); v0[1] *= bfhi(gw.x); v0[2] *= bflo(gw.y); v0[3] *= bfhi(gw.y); v1[0] *= bflo(gw.z); v1[1] *= bfhi(gw.z); v1[2] *= bflo(gw.w); v1[3] *= bfhi(gw.w);
                    if (!first) { const u32x4 pw = *(const u32x4*)(up + bj * 128);
                        v0[0] += bflo(pw.x); v0[1] += bfhi(pw.x); v0[2] += bflo(pw.y); v0[3] += bfhi(pw.y); v1[0] += bflo(pw.z); v1[1] += bfhi(pw.z); v1[2] += bflo(pw.w); v1[3] += bfhi(pw.w); }
                    u32x4 w; w.x = cvt_pk_bf16(v0[0], v0[1]); w.y = cvt_pk_bf16(v0[2], v0[3]); w.z = cvt_pk_bf16(v1[0], v1[1]); w.w = cvt_pk_bf16(v1[2], v1[3]);
                    *(u32x4*)(up + bj * 128) = w; }
                asm volatile("" ::: "memory"); }
    }
};
struct EpiBranchFused {
    static constexpr bool HAS_MID = true; static constexpr int MID0 = 16, MID1 = 48;
    const bf16_t* P; bf16_t* U;
    __device__ __forceinline__ void mid(f32x4 (&acc)[2][2][4][2], const pg8::Unit& u, int t, int wr, int wc) const {
        const int l_ = lane_now(), fr = l_ & 15, fq = l_ >> 4;
        const int row0 = u.pm * 256 + wr * 64 + fr, col0 = u.pn * 256 + wc * 32 + 8 * fq;
        const int cnum = t == MID0 ? C_GA : C_GB, cden = t == MID0 ? C_GB : C_GM;
#pragma unroll
        for (int ai = 0; ai < 2; ++ai)
#pragma unroll
            for (int m = 0; m < 4; ++m) { const bf16_t* gp = P + (size_t)(row0 + ai * 128 + m * 16) * N_IN + col0;
#pragma unroll
                for (int bj = 0; bj < 2; ++bj) { const u32x4 gn = *(const u32x4*)(gp + cnum + bj * 128), gd = *(const u32x4*)(gp + cden + bj * 128);
#define RAT(a, b) ((a) * __builtin_amdgcn_rcpf(fmaxf((b), 1e-30f)))
                    f32x4& v0 = acc[ai][bj][m][0]; f32x4& v1 = acc[ai][bj][m][1];
                    v0[0] *= RAT(bflo(gn.x), bflo(gd.x)); v0[1] *= RAT(bfhi(gn.x), bfhi(gd.x)); v0[2] *= RAT(bflo(gn.y), bflo(gd.y)); v0[3] *= RAT(bfhi(gn.y), bfhi(gd.y));
                    v1[0] *= RAT(bflo(gn.z), bflo(gd.z)); v1[1] *= RAT(bfhi(gn.z), bfhi(gd.z)); v1[2] *= RAT(bflo(gn.w), bflo(gd.w)); v1[3] *= RAT(bfhi(gn.w), bfhi(gd.w));
#undef RAT
                }
                asm volatile("" ::: "memory"); }
    }
    __device__ __forceinline__ void operator()(const f32x4 (&acc)[2][2][4][2], const pg8::Unit& u, int wr, int wc, int fr, int fq) const {
        const int row0 = u.pm * 256 + wr * 64 + fr, col0 = u.pn * 256 + wc * 32 + 8 * fq;
#pragma unroll
        for (int ai = 0; ai < 2; ++ai)
#pragma unroll
            for (int m = 0; m < 4; ++m) { const int row = row0 + ai * 128 + m * 16; const bf16_t* gp = P + (size_t)row * N_IN + C_GM + col0; bf16_t* up = U + (size_t)row * DM + col0;
#pragma unroll
                for (int bj = 0; bj < 2; ++bj) { const u32x4 gw = *(const u32x4*)(gp + bj * 128); f32x4 v0 = acc[ai][bj][m][0], v1 = acc[ai][bj][m][1];
                    v0[0] *= bflo(gw.x); v0[1] *= bfhi(gw.x); v0[2] *= bflo(gw.y); v0[3] *= bfhi(gw.y); v1[0] *= bflo(gw.z); v1[1] *= bfhi(gw.z); v1[2] *= bflo(gw.w); v1[3] *= bfhi(gw.w);
                    u32x4 w; w.x = cvt_pk_bf16(v0[0], v0[1]); w.y = cvt_pk_bf16(v0[2], v0[3]); w.z = cvt_pk_bf16(v1[0], v1[1]); w.w = cvt_pk_bf16(v1[2], v1[3]);
                    *(u32x4*)(up + bj * 128) = w; }
                asm volatile("" ::: "memory"); }
    }
};
struct EpiOut {
    static constexpr bool HAS_MID = false; static constexpr int MID0 = -1, MID1 = -1;
    const float* xp; const float* xs; float* out;
    __device__ __forceinline__ void operator()(const f32x4 (&acc)[2][2][4][2], const pg8::Unit& u, int wr, int wc, int fr, int fq) const {
        const int row0 = u.pm * 256 + wr * 64 + fr, col0 = u.pn * 256 + wc * 32 + 4 * fq;
#pragma unroll
        for (int ai = 0; ai < 2; ++ai)
#pragma unroll
            for (int m = 0; m < 4; ++m) { const int row = row0 + ai * 128 + m * 16;
                const float* xr = (row < M_PROMPT ? xp + (size_t)row * DM : xs + (size_t)(row - M_PROMPT) * DM) + col0; float* orow = out + (size_t)row * DM + col0;
#pragma unroll
                for (int bj = 0; bj < 2; ++bj)
#pragma unroll
                    for (int n = 0; n < 2; ++n) { const f32x4 xv = *(const f32x4*)(xr + bj * 128 + n * 16); *(f32x4*)(orow + bj * 128 + n * 16) = xv + acc[ai][bj][m][n]; }
                asm volatile("" ::: "memory"); }
    }
};

#define XB_TMO      128
#define XB_XCNT(j)  (256  + 64 * (j))
#define XB_XSUB(j)  (1280 + 64 * (j))
#define XB_XGEN(j)  (2304 + 64 * (j))
#define XB_TOP      3328
#define XB_TOPGEN   3392
#define XCD_BAR_WORDS 3456
#define XB_SPIN_CAP (1u << 18)
__device__ __forceinline__ unsigned xb_ld(unsigned* p)              { return __hip_atomic_load(p, __ATOMIC_RELAXED, __HIP_MEMORY_SCOPE_AGENT); }
__device__ __forceinline__ unsigned xb_add(unsigned* p, unsigned v) { return __hip_atomic_fetch_add(p, v, __ATOMIC_RELAXED, __HIP_MEMORY_SCOPE_AGENT); }
__device__ __forceinline__ unsigned xb_xcc_id() { return (unsigned)__builtin_amdgcn_s_getreg((3 << 11) | 20) & 0xFu; }
#define XB_SPIN(cond, bar) do { unsigned _sp = 0; while (cond) { __builtin_amdgcn_s_sleep(1); \
    if ((++_sp & 255u) == 0u) { if (xb_ld(&(bar)[XB_TMO])) break; if (_sp > XB_SPIN_CAP) { atomicAdd(&(bar)[XB_TMO], 1u); break; } } } } while (0)
struct XcdBarrier { unsigned* bar; unsigned x; volatile LAS unsigned* st; };
__device__ __forceinline__ XcdBarrier xcd_barrier_post(unsigned* bar, volatile LAS unsigned* st) {
    XcdBarrier b; b.bar = bar; b.x = xb_xcc_id(); b.st = st;
    if (threadIdx.x == 0) (void)xb_add(&bar[XB_XCNT(b.x)], 1u);
    return b;
}
__device__ __forceinline__ void xcd_barrier_complete(unsigned* bar, unsigned x, unsigned& nloc, unsigned& nx) {
    const unsigned G = gridDim.x * gridDim.y * gridDim.z;
    unsigned sum, cnt, mine, sp = 0u;
    for (;;) {
        sum = 0u; cnt = 0u; mine = 0u;
#pragma unroll
        for (unsigned j = 0; j < 16; ++j) { const unsigned c = xb_ld(&bar[XB_XCNT(j)]); sum += c; cnt += (c > 0u) ? 1u : 0u; mine = (j == x) ? c : mine; }
        if (sum == G) break;
        __builtin_amdgcn_s_sleep(1);
        if ((++sp & 255u) == 0u) { if (xb_ld(&bar[XB_TMO])) break; if (sp > XB_SPIN_CAP) { atomicAdd(&bar[XB_TMO], 1u); break; } }
    }
    nloc = mine > 0u ? mine : 1u; nx = cnt > 0u ? cnt : 1u;
}
__device__ __forceinline__ void xcd_barrier(const XcdBarrier& b) {
    asm volatile("s_waitcnt vmcnt(0)" ::: "memory");
    __syncthreads();
    if (threadIdx.x == 0) {
        unsigned* bar = b.bar;
        __builtin_amdgcn_s_waitcnt(0);
        unsigned nloc = b.st[0], nx = b.st[1];
        if (nloc == 0u) { xcd_barrier_complete(bar, b.x, nloc, nx); b.st[0] = nloc; b.st[1] = nx; }
        const unsigned old = xb_add(&bar[XB_XSUB(b.x)], 1u);
        const unsigned gen = old / nloc;
        if (old + 1u == (gen + 1u) * nloc) {
            __builtin_amdgcn_fence(__ATOMIC_RELEASE, "agent");
            asm volatile("s_waitcnt vmcnt(0)" ::: "memory");
            const unsigned og = xb_add(&bar[XB_TOP], 1u);
            const unsigned tg = og / nx;
            if (og + 1u == (tg + 1u) * nx) xb_add(&bar[XB_TOPGEN], 1u);
            else XB_SPIN(xb_ld(&bar[XB_TOPGEN]) == tg, bar);
            __builtin_amdgcn_fence(__ATOMIC_ACQUIRE, "agent");
            xb_add(&bar[XB_XGEN(b.x)], 1u);
            asm volatile("s_waitcnt vmcnt(0)" ::: "memory");
        } else {
            XB_SPIN(xb_ld(&bar[XB_XGEN(b.x)]) == gen, bar);
            __builtin_amdgcn_fence(__ATOMIC_ACQUIRE, "agent");
            asm volatile("s_waitcnt vmcnt(0)" ::: "memory");
        }
    }
    __syncthreads();
}

#define LDS_WAIT() asm volatile("s_waitcnt lgkmcnt(0)" ::: "memory")
__device__ __forceinline__ float wave_sum(float v) {
#pragma unroll
    for (int o = 1; o < 64; o <<= 1) v += __shfl_xor(v, o);
    return v;
}
__device__ __forceinline__ float wave_max(float v) {
#pragma unroll
    for (int o = 1; o < 64; o <<= 1) v = fmaxf(v, __shfl_xor(v, o));
    return v;
}
__device__ __forceinline__ int perm_std(int n) { const int s = n & 31; return (n & ~31) + 16 * ((s >> 2) & 1) + 4 * (s >> 3) + (s & 3); }
__device__ __forceinline__ int perm_rope(int n) { const int d = n & 127; return (n & ~127) + 32 * ((d & 63) >> 4) + 16 * (d >> 6) + (d & 15); }
__device__ __forceinline__ void transpose_item(const float* W, int ldw, int k0, int n0, bf16_t* WT, int ldt, int kdst0, int mode, LAS float* scr, int lane) {
#pragma unroll 8
    for (int i = 0; i < 32; ++i) { const int kk = 2 * i + (lane >> 5); scr[kk * 33 + (lane & 31)] = W[(size_t)(k0 + kk) * ldw + n0 + (lane & 31)]; }
    LDS_WAIT(); asm volatile("" ::: "memory");
    const int c = lane & 7;
#pragma unroll
    for (int j = 0; j < 4; ++j) { const int n = (lane >> 3) + 8 * j; const LAS float* s = scr + (8 * c) * 33 + n;
        u32x4 o; o.x = cvt_pk_bf16(s[0 * 33], s[1 * 33]); o.y = cvt_pk_bf16(s[2 * 33], s[3 * 33]); o.z = cvt_pk_bf16(s[4 * 33], s[5 * 33]); o.w = cvt_pk_bf16(s[6 * 33], s[7 * 33]);
        const int ns = n0 + n; int nd = ns;
        if (mode == 1) nd = perm_std(ns); else if (mode == 2) nd = (tile_type(ns >> 8) == 1) ? perm_rope(ns) : perm_std(ns);
        *(u32x4*)(WT + (size_t)nd * ldt + kdst0 + 8 * c) = o; }
    LDS_WAIT(); asm volatile("" ::: "memory");
}
__device__ __forceinline__ void rms_row_to_bf16(const float* xrow, const float* gain, bf16_t* orow, int lane) {
    const f32x4* xr = (const f32x4*)xrow + lane; f32x4 v[16]; float s = 0.f;
#pragma unroll
    for (int j = 0; j < 16; ++j) { v[j] = xr[64 * j]; s += (v[j][0] * v[j][0] + v[j][1] * v[j][1]) + (v[j][2] * v[j][2] + v[j][3] * v[j][3]); }
    const float rstd = 1.0f / sqrtf(wave_sum(s) * (1.0f / DM) + NORM_EPS);
    const f32x4* gr = (const f32x4*)gain + lane; u32x2* o = (u32x2*)orow + lane;
#pragma unroll
    for (int j = 0; j < 16; ++j) { const f32x4 g = gr[64 * j]; u32x2 w; w.x = cvt_pk_bf16(v[j][0] * rstd * g[0], v[j][1] * rstd * g[1]); w.y = cvt_pk_bf16(v[j][2] * rstd * g[2], v[j][3] * rstd * g[3]); o[64 * j] = w; }
}


#ifndef SELFCHECK
#define SELFCHECK 0
#endif
__device__ __forceinline__ float bf1(const bf16_t* p) { return __uint_as_float(((unsigned)*p) << 16); }
__device__ __forceinline__ float rbf(float x) { return bflo(cvt_pk_bf16(x, 0.f) & 0xffffu); }
__device__ __forceinline__ float dot_bf16(const bf16_t* a, const bf16_t* b, int K, float& sabs) {
    float s = 0.f; sabs = 0.f;
    for (int k = 0; k < K; k += 8) { const u32x4 av = *(const u32x4*)(a + k), bv = *(const u32x4*)(b + k);
        float p;
        p = bflo(av.x) * bflo(bv.x); s += p; sabs += fabsf(p); p = bfhi(av.x) * bfhi(bv.x); s += p; sabs += fabsf(p);
        p = bflo(av.y) * bflo(bv.y); s += p; sabs += fabsf(p); p = bfhi(av.y) * bfhi(bv.y); s += p; sabs += fabsf(p);
        p = bflo(av.z) * bflo(bv.z); s += p; sabs += fabsf(p); p = bfhi(av.z) * bfhi(bv.z); s += p; sabs += fabsf(p);
        p = bflo(av.w) * bflo(bv.w); s += p; sabs += fabsf(p); p = bfhi(av.w) * bfhi(bv.w); s += p; sabs += fabsf(p); }
    return s;
}
__device__ __forceinline__ unsigned hash32(unsigned x) { x ^= x >> 16; x *= 0x7feb352du; x ^= x >> 15; x *= 0x846ca68bu; x ^= x >> 16; return x; }
__device__ __forceinline__ int win_dest_row(int n) { return (tile_type(n >> 8) == 1) ? perm_rope(n) : perm_std(n); }

namespace att {
typedef float f32x16 __attribute__((ext_vector_type(16)));
typedef short s16x4 __attribute__((ext_vector_type(4)));
#define ATT_KSWZ(row, colB) ((row) * 256 + ((colB) ^ (((row) & 7) << 4)))
constexpr int BUF_BYTES = 49152, K0_OFF = 0, K1_OFF = 16384, V_OFF = 32768, WSCR_OFF = 2 * BUF_BYTES;
__device__ __forceinline__ int crow(int r, int hi) { return (r & 3) + 8 * (r >> 2) + 4 * hi; }
__device__ __forceinline__ int v_st(int k, int c) { const int kk = (k & ~0xC) | ((k & 4) << 1) | ((k & 8) >> 1); return ((kk >> 3) * 4 + (c >> 5)) * 512 + ((kk & 7) * 32 + (c & 31)) * 2; }
__device__ __forceinline__ int v_rd_base(int lane) { return ((lane & 3) << 3) | (((lane >> 2) & 3) << 6) | (((lane >> 4) & 1) << 5) | (((lane >> 5) & 1) << 8); }
constexpr int v_rd_off(int d0, int ks, int half) { return d0 * 512 + ks * 4096 + half * 2048; }
template <int OFF> __device__ __forceinline__ s16x4 tr_read(const LAS unsigned char* vb) { return __builtin_amdgcn_ds_read_tr16_b64_v4i16((LAS s16x4*)(vb + OFF)); }
template <int D0> __device__ __forceinline__ void pv_one(f32x16& od, const LAS unsigned char* vb, bf16x8 pa0, bf16x8 pa1, bf16x8 pa2, bf16x8 pa3) {
    const s16x4 l0 = tr_read<v_rd_off(D0, 0, 0)>(vb), h0 = tr_read<v_rd_off(D0, 0, 1)>(vb), l1 = tr_read<v_rd_off(D0, 1, 0)>(vb), h1 = tr_read<v_rd_off(D0, 1, 1)>(vb);
    const s16x4 l2 = tr_read<v_rd_off(D0, 2, 0)>(vb), h2 = tr_read<v_rd_off(D0, 2, 1)>(vb), l3 = tr_read<v_rd_off(D0, 3, 0)>(vb), h3 = tr_read<v_rd_off(D0, 3, 1)>(vb);
#define ATT_PK(L, H) (bf16x8){L[0], L[1], L[2], L[3], H[0], H[1], H[2], H[3]}
    od = __builtin_amdgcn_mfma_f32_32x32x16_bf16(ATT_PK(l0, h0), pa0, od, 0, 0, 0);
    od = __builtin_amdgcn_mfma_f32_32x32x16_bf16(ATT_PK(l1, h1), pa1, od, 0, 0, 0);
    od = __builtin_amdgcn_mfma_f32_32x32x16_bf16(ATT_PK(l2, h2), pa2, od, 0, 0, 0);
    od = __builtin_amdgcn_mfma_f32_32x32x16_bf16(ATT_PK(l3, h3), pa3, od, 0, 0, 0);
#undef ATT_PK
}
__device__ __forceinline__ void qkt_acc(f32x16& p0, f32x16& p1, const LAS unsigned char* Ks, const bf16x8* qr, int r32, int hi) {
#pragma unroll
    for (int d0 = 0; d0 < 8; ++d0) { const int cb = (d0 * 16 + hi * 8) * 2;
        const bf16x8 b0 = *(const LAS bf16x8*)(Ks + ATT_KSWZ(r32, cb));
        const bf16x8 b1 = *(const LAS bf16x8*)(Ks + ATT_KSWZ(32 + r32, cb));
        p0 = __builtin_amdgcn_mfma_f32_32x32x16_bf16(b0, qr[d0], p0, 0, 0, 0);
        p1 = __builtin_amdgcn_mfma_f32_32x32x16_bf16(b1, qr[d0], p1, 0, 0, 0); }
}
template <int DQK, int R>
__device__ __forceinline__ void attn_unit(LAS unsigned char* lds, int tid, int wave, int lane,
                                          const bf16_t* qlane  , const bf16_t* kbase, const bf16_t* vbase, size_t kvstride  ,
                                          int kt0, int ntiles, int jw  , float C  , float thr_raw  ,
                                          f32x16 (&o)[4], float& m_reg, float& l_reg) {
    constexpr int NKC = DQK / 128;
    const int r32 = lane & 31, hi = lane >> 5;
    bf16x8 qr[8 * NKC];
#pragma unroll
    for (int c = 0; c < 8 * NKC; ++c) qr[c] = *(const bf16x8*)(qlane + 16 * c);
    unsigned koff[2], voff[2];
#pragma unroll
    for (int i = 0; i < 2; ++i) { const int b = i * 8192 + tid * 16;
        { const int row = b >> 8, colB = (b & 255) ^ ((row & 7) << 4); koff[i] = (unsigned)(((size_t)row * kvstride + (colB >> 1)) * 2); }
        { const int sub = b >> 9, within = (b & 511) >> 1, kk = (sub >> 2) * 8 + (within >> 5), k = (kk & ~0xC) | ((kk & 4) << 1) | ((kk & 8) >> 1), c = (sub & 3) * 32 + (within & 31); voff[i] = (unsigned)(((size_t)k * kvstride + c) * 2); } }
    const unsigned ldsw = (unsigned)wave * 1024u;
#define ATT_LOAD(t, b) do { const char* kp = (const char*)(kbase + (size_t)(kt0 + 64 * (t)) * kvstride); const char* vp = (const char*)(vbase + (size_t)(kt0 + 64 * (t)) * kvstride); LAS unsigned char* bb_ = lds + (b) * BUF_BYTES; \
        _Pragma("unroll") for (int c = 0; c < NKC; ++c) _Pragma("unroll") for (int i = 0; i < 2; ++i) \
            __builtin_amdgcn_global_load_lds((const unsigned*)(kp + 256 * c + koff[i]), (LAS unsigned*)(bb_ + K0_OFF + c * 16384 + i * 8192 + ldsw), 16, 0, 0); \
        _Pragma("unroll") for (int i = 0; i < 2; ++i) __builtin_amdgcn_global_load_lds((const unsigned*)(vp + voff[i]), (LAS unsigned*)(bb_ + V_OFF + i * 8192 + ldsw), 16, 0, 0); } while (0)
    __syncthreads();
    ATT_LOAD(0, 0);
    for (int t = 0; t < ntiles; ++t) {
        const int b = t & 1;
        asm volatile("s_waitcnt vmcnt(0)" ::: "memory");
        __syncthreads();
        if (t + 1 < ntiles) ATT_LOAD(t + 1, b ^ 1);
        const int kt = kt0 + 64 * t;
        if (R == 0 || (kt <= jw + 31 + R && kt + 63 >= jw - R)) {
            const LAS unsigned char* bb = lds + b * BUF_BYTES;
            f32x16 p0, p1;
#pragma unroll
            for (int r = 0; r < 16; ++r) { p0[r] = 0.f; p1[r] = 0.f; }
            qkt_acc(p0, p1, bb + K0_OFF, qr, r32, hi);
            if (NKC == 2) qkt_acc(p0, p1, bb + K1_OFF, qr + 8 * (NKC - 1), r32, hi);
            if (R != 0 && !(kt >= jw + 31 - R && kt + 63 <= jw + R)) {
                const int dq = kt - (jw + r32) + R + 4 * hi; const float NEG = -__builtin_inff();
#pragma unroll
                for (int r = 0; r < 16; ++r) { const int c = (r & 3) + 8 * (r >> 2);
                    if ((unsigned)(dq + c) > (unsigned)(2 * R)) p0[r] = NEG;
                    if ((unsigned)(dq + c + 32) > (unsigned)(2 * R)) p1[r] = NEG; }
            }
            float pmax = p0[0];
#pragma unroll
            for (int r = 1; r < 16; ++r) pmax = fmaxf(pmax, p0[r]);
#pragma unroll
            for (int r = 0; r < 16; ++r) pmax = fmaxf(pmax, p1[r]);
            { auto rr = __builtin_amdgcn_permlane32_swap(__float_as_uint(pmax), __float_as_uint(pmax), false, false); pmax = fmaxf(__uint_as_float(rr[0]), __uint_as_float(rr[1])); }
            float mn, alpha;
            if (__all(pmax - m_reg <= thr_raw)) { mn = m_reg; alpha = 1.f; }
            else { mn = fmaxf(m_reg, pmax); alpha = __builtin_amdgcn_exp2f((m_reg - mn) * C); m_reg = mn; }
            const float mnC = -mn * C; float ps = 0.f;
#pragma unroll
            for (int r = 0; r < 16; ++r) { p0[r] = __builtin_amdgcn_exp2f(fmaf(p0[r], C, mnC)); p1[r] = __builtin_amdgcn_exp2f(fmaf(p1[r], C, mnC)); ps += p0[r] + p1[r]; }
            { auto rr = __builtin_amdgcn_permlane32_swap(__float_as_uint(ps), __float_as_uint(ps), false, false); ps = __uint_as_float(rr[0]) + __uint_as_float(rr[1]); }
            l_reg = l_reg * alpha + ps;
            bf16x8 pa0, pa1, pa2, pa3;
#define ATT_PK4(Pv, B_, OUT) do { const unsigned a0 = cvt_pk_bf16(Pv[B_ + 0], Pv[B_ + 1]), a1 = cvt_pk_bf16(Pv[B_ + 2], Pv[B_ + 3]), b0 = cvt_pk_bf16(Pv[B_ + 4], Pv[B_ + 5]), b1 = cvt_pk_bf16(Pv[B_ + 6], Pv[B_ + 7]); \
        auto r0 = __builtin_amdgcn_permlane32_swap(a0, b0, false, false); auto r1 = __builtin_amdgcn_permlane32_swap(a1, b1, false, false); \
        u32x4 w = {r0[0], r1[0], r0[1], r1[1]}; OUT = __builtin_bit_cast(bf16x8, w); } while (0)
            ATT_PK4(p0, 0, pa0); ATT_PK4(p0, 8, pa1); ATT_PK4(p1, 0, pa2); ATT_PK4(p1, 8, pa3);
#undef ATT_PK4
            if (__any(alpha < 1.f)) {
#pragma unroll
                for (int r = 0; r < 16; ++r)
#pragma unroll
                    for (int d = 0; d < 4; ++d) o[d][r] *= alpha;
            }
            const LAS unsigned char* vb = bb + V_OFF + v_rd_base(lane);
            pv_one<0>(o[0], vb, pa0, pa1, pa2, pa3); pv_one<1>(o[1], vb, pa0, pa1, pa2, pa3); pv_one<2>(o[2], vb, pa0, pa1, pa2, pa3); pv_one<3>(o[3], vb, pa0, pa1, pa2, pa3);
        }
    }
#undef ATT_LOAD
}
__device__ __forceinline__ void row_inv(LAS unsigned char* lds, int wave, int lane, float l_reg, float (&rli)[16]) {
    LAS float* li_l = (LAS float*)(lds + WSCR_OFF + wave * 256 + 128); const int r32 = lane & 31, hi = lane >> 5;
    if (hi == 0) li_l[r32] = l_reg;
    asm volatile("s_waitcnt lgkmcnt(0)" ::: "memory");
#pragma unroll
    for (int r = 0; r < 16; ++r) rli[r] = __builtin_amdgcn_rcpf(li_l[crow(r, hi)]);
    asm volatile("s_waitcnt lgkmcnt(0)" ::: "memory");
}
__device__ __forceinline__ void st_bf16(bf16_t* p, float v) { *p = (bf16_t)(cvt_pk_bf16(v, 0.f) & 0xffffu); }
template <class F>
__device__ __forceinline__ void emit_rows(LAS unsigned char* slab, int lane, const f32x16 (&o)[4], float rl, F emit) {
    const int r32 = lane & 31, hi = lane >> 5;
#pragma unroll
    for (int h = 0; h < 2; ++h) {
#pragma unroll
        for (int dd = 0; dd < 2; ++dd)
#pragma unroll
            for (int g = 0; g < 4; ++g) { const int d = 2 * h + dd; u32x2 w; w.x = cvt_pk_bf16(o[d][4 * g + 0] * rl, o[d][4 * g + 1] * rl); w.y = cvt_pk_bf16(o[d][4 * g + 2] * rl, o[d][4 * g + 3] * rl);
                *(LAS u32x2*)(slab + r32 * 144 + (32 * dd + 8 * g + 4 * hi) * 2) = w; }
#pragma unroll
        for (int i = 0; i < 4; ++i) { const int row = 8 * i + (lane >> 3), c16 = lane & 7; const u32x4 v = *(const LAS u32x4*)(slab + row * 144 + c16 * 16); emit(row, 64 * h + 8 * c16, v); }
    }
}
__device__ __forceinline__ u32x4 mul_bf16x8(u32x4 a, u32x4 b) {
    u32x4 w; w.x = cvt_pk_bf16(bflo(a.x) * bflo(b.x), bfhi(a.x) * bfhi(b.x)); w.y = cvt_pk_bf16(bflo(a.y) * bflo(b.y), bfhi(a.y) * bfhi(b.y));
    w.z = cvt_pk_bf16(bflo(a.z) * bflo(b.z), bfhi(a.z) * bfhi(b.z)); w.w = cvt_pk_bf16(bflo(a.w) * bflo(b.w), bfhi(a.w) * bfhi(b.w)); return w;
}
}

__device__ __forceinline__ void seq_of_row(int row, int& seq0, int& pos, int& S) {
    if (row < M_PROMPT) { S = 4096; pos = row & 4095; } else { S = 8192; pos = row & 8191; }
    seq0 = row - pos;
}

struct Args { const float* in[12]; float* out; unsigned char* ws; };
__global__ void __launch_bounds__(NWAVES * 64, 2) fwd_kernel(Args args) {
    extern __shared__ __attribute__((aligned(16))) unsigned char lds_raw[];
    LAS unsigned char* lds = (LAS unsigned char*)lds_raw;
    volatile LAS unsigned* MISC = (volatile LAS unsigned*)(lds + MISC_OFF);
    const int tid = threadIdx.x, lane = tid & 63, wave = __builtin_amdgcn_readfirstlane(tid >> 6);
    const int G = gridDim.x, bx = blockIdx.x, vcu = (G % 8 == 0) ? (bx % 8) * (G / 8) + bx / 8 : bx;
    unsigned char* ws = args.ws; unsigned char* dout = (unsigned char*)args.out;
    unsigned* ctl = (unsigned*)(ws + WS_CTL);
    const float* x_prompt = args.in[0]; const float* x_sample = args.in[1]; const float* mem_prompt = args.in[2]; const float* mem_sample = args.in[3];
    const float* g_norm = args.in[4]; const float* w_in = args.in[5]; const float* attn_sink = args.in[6]; const float* g_mem = args.in[7];
    const float* w_mem_kv = args.in[8]; const float* w_branch = args.in[9]; const float* w_out = args.in[10]; const float* g_final = args.in[11];
    f32x2* ROPE = (f32x2*)(ws + WS_ROPE); bf16_t* MKV = (bf16_t*)(ws + WS_MKV);
    bf16_t* WBT_A = (bf16_t*)(ws + WS_WBT_A); bf16_t* WBT_B = (bf16_t*)(ws + WS_WBT_B); bf16_t* WBT_M = (bf16_t*)(ws + WS_WBT_M);
    bf16_t* WOT = (bf16_t*)(ws + WS_WOT); bf16_t* WINT = (bf16_t*)(ws + WS_WINT); bf16_t* U = (bf16_t*)(ws + WS_U); bf16_t* P = (bf16_t*)(ws + WS_P);
    bf16_t* H = (bf16_t*)(dout + DO_H); bf16_t* AZA = (bf16_t*)(dout + DO_AZA); bf16_t* AZB = AZA + 1024; bf16_t* AZM = AZA + 3072;     bf16_t* OG = (bf16_t*)(dout + DO_OG); float* LSE = (float*)(dout + DO_LSE);

    for (int u = tid; u < (LDS_BYTES - LDSCTL_OFF) / 4; u += NWAVES * 64) ((LAS unsigned*)(lds + LDSCTL_OFF))[u] = 0u;
    __syncthreads();
    XcdBarrier bar = xcd_barrier_post(ctl + CW_BAR, MISC + 8);
    const int gw = vcu * NWAVES + wave, NGW = G * NWAVES;

    {
        LAS float* scr = (LAS float*)(lds + wave * 16384);
        constexpr int I_IN = 64 * (N_IN / 32), I_KV = 64 * (N_KV / 32), I_BR = 64 * (DM / 32), I_OUT = 64 * (DM / 32);
        constexpr int NITEMS = I_IN + I_KV + I_BR + I_OUT;
        for (int it = gw; it < NITEMS; it += NGW) {
            int r = it;
            if (r < I_IN) { const int nb = r % (N_IN / 32), kb = r / (N_IN / 32); transpose_item(w_in, N_IN, 64 * kb, 32 * nb, WINT, DM, 64 * kb, 2, scr, lane); continue; } r -= I_IN;
            if (r < I_KV) { const int nb = r % (N_KV / 32), kb = r / (N_KV / 32); transpose_item(w_mem_kv, N_KV, 64 * kb, 32 * nb, WINT + (size_t)N_IN * DM, DM, 64 * kb, 1, scr, lane); continue; } r -= I_KV;
            if (r < I_BR) { const int nb = r % (DM / 32), kb = r / (DM / 32); const int k0 = 64 * kb;
                transpose_item(w_branch, DM, k0, 32 * nb, WBT_A, DM, k0, 1, scr, lane);
                continue; } r -= I_BR;
            { const int nb = r % (DM / 32), kb = r / (DM / 32); transpose_item(w_out, DM, 64 * kb, 32 * nb, WOT, DM, 64 * kb, 0, scr, lane); }
        }
        for (int m = gw; m < M_ALL; m += NGW) {
            const float* xr; const float* gn = g_norm;
            if (m < M_PROMPT) xr = x_prompt + (size_t)m * DM; else if (m < M_TOK) xr = x_sample + (size_t)(m - M_PROMPT) * DM;
            else if (m < M_TOK + 512) { xr = mem_prompt + (size_t)(m - M_TOK) * DM; gn = g_mem; } else { xr = mem_sample + (size_t)(m - M_TOK - 512) * DM; gn = g_mem; }
            rms_row_to_bf16(xr, gn, H + (size_t)m * DM, lane);
        }
        for (int e = (bx * NWAVES * 64 + tid); e < 8192 * 64; e += G * NWAVES * 64) {
            const int pos = e >> 6, i = e & 63;
            const float inv_freq = (float)pow(10000.0, -(double)(2 * i) / 128.0);
            const float ang = (float)pos * inv_freq;
            f32x2 cs; cs[0] = (float)cos((double)ang); cs[1] = (float)sin((double)ang); ROPE[e] = cs;
        }
    }
    xcd_barrier(bar);

    {
        pg8::Gemm g{H, WINT, DM, DM, DM}; pg8::StaticOrder S; S.init(M_TOK / 256, N_IN / 256, G, bx); S.extra = 32; S.xm0 = 96; S.xn0 = 116; S.xw = 8;
        EpiProj E{P, MKV, (const f32x4*)ROPE};
        pg8::gemm_phase<EpiProj>(lds, g, S, E);
    }
    xcd_barrier(bar);


#if SELFCHECK
    {
        const unsigned gt = (unsigned)bx * 512u + (unsigned)tid; const unsigned hsh = hash32(gt * 2654435761u + 12345u);
        const int row = (int)(hsh % (unsigned)M_TOK); const int col = (int)(hash32(hsh + 77u) % (unsigned)N_IN);
        const int ty = tile_type(col >> 8); float sa, ref; const bf16_t* hrow = H + (size_t)row * DM;
        if (ty == 1) { const int d = col & 127, dl = d & 63, c1 = (col & ~127) + dl, c2 = c1 + 64; float sa2;
            const float x1 = dot_bf16(hrow, WINT + (size_t)win_dest_row(c1) * DM, DM, sa), x2 = dot_bf16(hrow, WINT + (size_t)win_dest_row(c2) * DM, DM, sa2); sa += sa2;
            const int pos = row < M_PROMPT ? (row & 4095) : (row & 8191); const f32x2 cs = ROPE[pos * 64 + dl];
            ref = d < 64 ? x1 * cs[0] - x2 * cs[1] : x2 * cs[0] + x1 * cs[1]; }
        else { const float a = dot_bf16(hrow, WINT + (size_t)win_dest_row(col) * DM, DM, sa); ref = ty == 2 ? a / (1.f + expf(-a)) : (ty == 3 ? 1.f / (1.f + expf(-a)) : a); }
        const float got = bf1(P + (size_t)row * N_IN + col);
        if (!(fabsf(got - ref) <= 0.01f * fabsf(ref) + 2e-4f * sa + 1e-3f)) atomicAdd(ctl + 16, 1u);
        if (gt < 65536u) { const int mr = (int)(hsh % 1024u), mc = (int)(hash32(hsh + 99u) % 2048u);
            const float a = dot_bf16(H + (size_t)(M_TOK + mr) * DM, WINT + (size_t)(N_IN + perm_std(mc)) * DM, DM, sa); const float g2 = bf1(MKV + (size_t)mr * N_KV + mc);
            if (!(fabsf(g2 - a) <= 0.01f * fabsf(a) + 2e-4f * sa + 1e-3f)) atomicAdd(ctl + 17, 1u); }

        {
            const int hr = (int)(hash32(hsh + 1234u) % (unsigned)M_ALL), hc = (int)(hash32(hsh + 4321u) % (unsigned)DM);
            const float* xr; const float* gn = g_norm;
            if (hr < M_PROMPT) xr = x_prompt + (size_t)hr * DM; else if (hr < M_TOK) xr = x_sample + (size_t)(hr - M_PROMPT) * DM;
            else if (hr < M_TOK + 512) { xr = mem_prompt + (size_t)(hr - M_TOK) * DM; gn = g_mem; } else { xr = mem_sample + (size_t)(hr - M_TOK - 512) * DM; gn = g_mem; }
            double ss = 0.0; for (int k = 0; k < DM; ++k) ss += (double)xr[k] * (double)xr[k];
            const double hv = (double)xr[hc] / sqrt(ss / DM + 1e-6) * (double)gn[hc]; const float gh = bf1(H + (size_t)hr * DM + hc);
            if (!(fabs((double)gh - hv) <= 0.005 * fabs(hv) + 1e-6)) atomicAdd(ctl + 23, 1u);
            const int wk = (int)(hash32(hsh + 555u) % (unsigned)DM), wn = (int)(hash32(hsh + 666u) % (unsigned)N_IN);
            const float wv = w_in[(size_t)wk * N_IN + wn]; const float gwv = bf1(WINT + (size_t)win_dest_row(wn) * DM + wk);
            if (!(fabsf(gwv - wv) <= 0.005f * fabsf(wv) + 1e-9f)) atomicAdd(ctl + 24, 1u);
            const int kk = (int)(hash32(hsh + 777u) % (unsigned)DM), kn = (int)(hash32(hsh + 888u) % (unsigned)N_KV);
            const float wv2 = w_mem_kv[(size_t)kk * N_KV + kn]; const float gw2 = bf1(WINT + (size_t)(N_IN + perm_std(kn)) * DM + kk);
            if (!(fabsf(gw2 - wv2) <= 0.005f * fabsf(wv2) + 1e-9f)) atomicAdd(ctl + 24, 1u);
            const int bk = (int)(hash32(hsh + 999u) % (unsigned)DM), bn = (int)(hash32(hsh + 1111u) % (unsigned)DM);
            const float wb = w_branch[(size_t)bk * DM + bn]; const int pcn = perm_std(bn);
            const float gwb = bf1(WBT_A + (size_t)pcn * DM + bk);
            if (!(fabsf(gwb - wb) <= 0.005f * fabsf(wb) + 1e-9f)) atomicAdd(ctl + 24, 1u);
            const float wo = w_out[(size_t)bk * DM + bn]; const float gwo = bf1(WOT + (size_t)bn * DM + bk);
            if (!(fabsf(gwo - wo) <= 0.005f * fabsf(wo) + 1e-9f)) atomicAdd(ctl + 24, 1u);
        }
    }
    xcd_barrier(bar);
#endif

    {
        constexpr float L2E = 1.4426950408889634f, SC128 = 0.08838834764831845f, SC256 = 0.0625f;
        constexpr int NU_B = (M_TOK / 64) * 4, NU_A = 3 * (M_TOK / 256) * 8, NU_M = (M_TOK / 256) * 8, NU = NU_B + NU_A + NU_M;
        const int r32 = lane & 31, hi = lane >> 5;
        for (int u = bx; u < NU_B; u += G) {
            att::f32x16 o[4];
#pragma unroll
            for (int d = 0; d < 4; ++d)
#pragma unroll
                for (int r = 0; r < 16; ++r) o[d][r] = 0.f;
            float m_reg = -1e30f, l_reg = 0.f;
            {
                const int blk = u >> 2, hk = u & 3; int seq0, pos0, S; seq_of_row(blk * 64, seq0, pos0, S);
                const int hq = hk * 4 + (wave >> 1), jw = pos0 + 32 * (wave & 1);
                int klo = pos0 - 128; if (klo < 0) klo = 0; int khi = pos0 + 192; if (khi > S) khi = S;
                const float C = SC128 * L2E;
                att::attn_unit<128, 128>(lds, tid, wave, lane, P + (size_t)(seq0 + jw + r32) * N_IN + C_BQ + hq * 128 + 8 * hi,
                                         P + (size_t)seq0 * N_IN + C_BK + hk * 128, P + (size_t)seq0 * N_IN + C_BV + hk * 128, (size_t)N_IN, klo, (khi - klo) >> 6, jw, C, 8.f / SC128, o, m_reg, l_reg);
                l_reg += __builtin_amdgcn_exp2f(attn_sink[hq] * L2E - m_reg * C);
                { const bf16_t* zb = P + (size_t)(seq0 + jw) * N_IN + C_ZB + hq * 128; bf16_t* ob = AZB + (size_t)(seq0 + jw) * DM + hq * 128;
                  att::emit_rows(lds + (((khi - klo) >> 6) & 1) * att::BUF_BYTES + wave * 4608, lane, o, __builtin_amdgcn_rcpf(l_reg),
                                 [&](int row, int col, u32x4 v) { const u32x4 zz = *(const u32x4*)(zb + (size_t)row * N_IN + col); *(u32x4*)(ob + (size_t)row * DM + col) = att::mul_bf16x8(v, zz); }); }
            }
        }
        for (int u = NU_B + bx; u < NU_B + NU_A; u += G) {
            att::f32x16 o[4];
#pragma unroll
            for (int d = 0; d < 4; ++d)
#pragma unroll
                for (int r = 0; r < 16; ++r) o[d][r] = 0.f;
            float m_reg = -1e30f, l_reg = 0.f;
            {
                const int v = u - NU_B, g = v / ((M_TOK / 256) * 8), rem = v % ((M_TOK / 256) * 8), head = rem & 7, blk = rem >> 3;
                const int dl = g == 0 ? 1 : (g == 1 ? 4 : 16); int seq0, pos0, S; seq_of_row(blk * 256, seq0, pos0, S);
                const int ui = pos0 >> 8, res = ui % dl, j0 = (ui / dl) * 256, SD = S / dl, jw = j0 + 32 * wave;
                int klo = j0 - 64; if (klo < 0) klo = 0; int khi = j0 + 320; if (khi > SD) khi = SD;
                const int hc = g * 1024 + head * 128; const float C = SC128 * L2E;
                att::attn_unit<128, 64>(lds, tid, wave, lane, P + (size_t)(seq0 + (jw + r32) * dl + res) * N_IN + C_AQ + hc + 8 * hi,
                                        P + (size_t)(seq0 + res) * N_IN + C_AK + hc, P + (size_t)(seq0 + res) * N_IN + C_AV + hc, (size_t)dl * N_IN, klo, (khi - klo) >> 6, jw, C, 8.f / SC128, o, m_reg, l_reg);
                { bf16_t* ob = OG + ((size_t)g * M_TOK + (size_t)(seq0 + jw * dl + res)) * 1024 + head * 128;
                  att::emit_rows(lds + (((khi - klo) >> 6) & 1) * att::BUF_BYTES + wave * 4608, lane, o, __builtin_amdgcn_rcpf(l_reg),
                                 [&](int row, int col, u32x4 v) { *(u32x4*)(ob + (size_t)row * dl * 1024 + col) = v; }); }
                if (hi == 0) LSE[((size_t)g * M_TOK + (size_t)(seq0 + (jw + r32) * dl + res)) * 8 + head] = m_reg * SC128 + __logf(l_reg);
            }
        }
        for (int u = NU_B + NU_A + bx; u < NU; u += G) {
            att::f32x16 o[4];
#pragma unroll
            for (int d = 0; d < 4; ++d)
#pragma unroll
                for (int r = 0; r < 16; ++r) o[d][r] = 0.f;
            float m_reg = -1e30f, l_reg = 0.f;
            {
                const int v = u - NU_B - NU_A, half = v & 1, hm = (v >> 1) & 3, blk = v >> 3; const int row0 = blk * 256;
                const int seq = row0 < M_PROMPT ? (row0 >> 12) : 2 + ((row0 - M_PROMPT) >> 13); const int jw = 32 * wave; const float C = SC256 * L2E;
                const bf16_t* kb = MKV + (size_t)(seq * 256) * N_KV + hm * 256;
                att::attn_unit<256, 0>(lds, tid, wave, lane, P + (size_t)(row0 + jw + r32) * N_IN + C_MQ + hm * 256 + 8 * hi, kb, kb + 1024 + half * 128, (size_t)N_KV, 0, 4, jw, C, 8.f / SC256, o, m_reg, l_reg);
                { const bf16_t* zb = P + (size_t)(row0 + jw) * N_IN + C_ZM + hm * 256 + half * 128; bf16_t* ob = AZM + (size_t)(row0 + jw) * DM + hm * 256 + half * 128;
                  att::emit_rows(lds + 0 * att::BUF_BYTES + wave * 4608, lane, o, __builtin_amdgcn_rcpf(l_reg),
                                 [&](int row, int col, u32x4 v) { const u32x4 zz = *(const u32x4*)(zb + (size_t)row * N_IN + col); *(u32x4*)(ob + (size_t)row * DM + col) = att::mul_bf16x8(v, zz); }); }
            }
        }
    }
    xcd_barrier(bar);
    {
        for (int m = gw; m < M_TOK; m += NGW) {
            const int head = lane >> 3, c0 = lane * 16;
            const float l0 = LSE[((size_t)0 * M_TOK + m) * 8 + head], l1 = LSE[((size_t)1 * M_TOK + m) * 8 + head], l2 = LSE[((size_t)2 * M_TOK + m) * 8 + head];
            const float mx = fmaxf(l0, fmaxf(l1, l2)); float a0 = __expf(l0 - mx), a1 = __expf(l1 - mx), a2 = __expf(l2 - mx); const float inv = 1.0f / (a0 + a1 + a2); a0 *= inv; a1 *= inv; a2 *= inv;
#pragma unroll
            for (int hh = 0; hh < 2; ++hh) {
                const u32x4 g0 = *(const u32x4*)(OG + ((size_t)0 * M_TOK + m) * 1024 + c0 + 8 * hh), g1 = *(const u32x4*)(OG + ((size_t)1 * M_TOK + m) * 1024 + c0 + 8 * hh), g2 = *(const u32x4*)(OG + ((size_t)2 * M_TOK + m) * 1024 + c0 + 8 * hh);
                const u32x4 zz = *(const u32x4*)(P + (size_t)m * N_IN + C_ZA + c0 + 8 * hh); u32x4 w;
#define CMB(f) cvt_pk_bf16((a0 * bflo(g0.f) + a1 * bflo(g1.f) + a2 * bflo(g2.f)) * bflo(zz.f), (a0 * bfhi(g0.f) + a1 * bfhi(g1.f) + a2 * bfhi(g2.f)) * bfhi(zz.f))
                w.x = CMB(x); w.y = CMB(y); w.z = CMB(z); w.w = CMB(w);
#undef CMB
                *(u32x4*)(AZA + (size_t)m * DM + c0 + 8 * hh) = w;
            }
        }
    }
    xcd_barrier(bar);

#if SELFCHECK
    {
        const unsigned gt = (unsigned)bx * 512u + (unsigned)tid; const unsigned hsh = hash32(gt * 2654435761u + 31337u);
        const int row = (int)(hsh % (unsigned)M_TOK); int seq0, pos, S; seq_of_row(row, seq0, pos, S);
        const int which = (int)(gt % 3u);
        if (which == 0) {
            const int hs = (int)(hash32(hsh + 1u) % 8u), d = (int)(hash32(hsh + 2u) % 128u);
            double mx = -1e300, den = 0.0, acc = 0.0;
            for (int pass = 0; pass < 2; ++pass)
                for (int gi = 0; gi < 3; ++gi) { const int dd = gi == 0 ? 1 : (gi == 1 ? 4 : 16); const int tlo = min(64, pos / dd), thi = min(64, (S - 1 - pos) / dd); const int hc = gi * 1024 + hs * 128;
                    const bf16_t* qp = P + (size_t)row * N_IN + C_AQ + hc;
                    for (int t = -tlo; t <= thi; ++t) { const bf16_t* kp = P + (size_t)(row + t * dd) * N_IN + C_AK + hc; double sdot = 0.0;
                        for (int k = 0; k < 128; ++k) sdot += (double)bf1(qp + k) * (double)bf1(kp + k);
                        sdot *= 0.08838834764831845;
                        if (pass == 0) mx = sdot > mx ? sdot : mx; else { const double e = exp(sdot - mx); den += e; acc += e * (double)bf1(P + (size_t)(row + t * dd) * N_IN + C_AV + hc + d); } } }
            const double ref = acc / den * (double)bf1(P + (size_t)row * N_IN + C_ZA + hs * 128 + d); const double got = (double)bf1(AZA + (size_t)row * DM + hs * 128 + d);
            if (!(fabs(got - ref) <= 0.02 * fabs(ref) + 4e-4)) atomicAdd(ctl + 20, 1u);
        } else if (which == 1) {
            const int hq = (int)(hash32(hsh + 1u) % 16u), hk = hq >> 2, d = (int)(hash32(hsh + 2u) % 128u);
            const double sk = (double)attn_sink[hq]; double mx = sk, den = 0.0, acc = 0.0; const int tlo = min(128, pos), thi = min(128, S - 1 - pos);
            const bf16_t* qp = P + (size_t)row * N_IN + C_BQ + hq * 128;
            for (int pass = 0; pass < 2; ++pass)
                for (int t = -tlo; t <= thi; ++t) { const bf16_t* kp = P + (size_t)(row + t) * N_IN + C_BK + hk * 128; double sdot = 0.0;
                    for (int k = 0; k < 128; ++k) sdot += (double)bf1(qp + k) * (double)bf1(kp + k);
                    sdot *= 0.08838834764831845;
                    if (pass == 0) mx = sdot > mx ? sdot : mx; else { const double e = exp(sdot - mx); den += e; acc += e * (double)bf1(P + (size_t)(row + t) * N_IN + C_BV + hk * 128 + d); } }
            den += exp(sk - mx);
            const double ref = acc / den * (double)bf1(P + (size_t)row * N_IN + C_ZB + hq * 128 + d); const double got = (double)bf1(AZB + (size_t)row * DM + hq * 128 + d);
            if (!(fabs(got - ref) <= 0.02 * fabs(ref) + 4e-4)) atomicAdd(ctl + 21, 1u);
        } else {
            const int hm = (int)(hash32(hsh + 1u) % 4u), d = (int)(hash32(hsh + 2u) % 256u); const int seq = row < M_PROMPT ? (row >> 12) : 2 + ((row - M_PROMPT) >> 13);
            double mx = -1e300, den = 0.0, acc = 0.0; const bf16_t* qp = P + (size_t)row * N_IN + C_MQ + hm * 256;
            for (int pass = 0; pass < 2; ++pass)
                for (int j = 0; j < 256; ++j) { const bf16_t* kp = MKV + (size_t)(seq * 256 + j) * N_KV + hm * 256; double sdot = 0.0;
                    for (int k = 0; k < 256; ++k) sdot += (double)bf1(qp + k) * (double)bf1(kp + k);
                    sdot *= 0.0625;
                    if (pass == 0) mx = sdot > mx ? sdot : mx; else { const double e = exp(sdot - mx); den += e; acc += e * (double)bf1(kp + 1024 + d); } }
            const double ref = acc / den * (double)bf1(P + (size_t)row * N_IN + C_ZM + hm * 256 + d); const double got = (double)bf1(AZM + (size_t)row * DM + hm * 256 + d);
            if (!(fabs(got - ref) <= 0.02 * fabs(ref) + 4e-4)) atomicAdd(ctl + 22, 1u);
        }
    }
    xcd_barrier(bar);
#endif

    {
        pg8::StaticOrder S; S.init(M_TOK / 256, DM / 256, G, bx);
        { pg8::Gemm g{AZA, WBT_A, DM, DM, DM}; EpiBranchFused E{P, U}; pg8::gemm_phase<EpiBranchFused>(lds, g, S, E); }
    }
    xcd_barrier(bar);


#if SELFCHECK
    {
        const unsigned gt = (unsigned)bx * 512u + (unsigned)tid; const unsigned hsh = hash32(gt * 2654435761u + 999u);
        const int row = (int)(hsh % (unsigned)M_TOK); const int col = (int)(hash32(hsh + 7u) % (unsigned)DM); const int pc = perm_std(col);
        float sa, sb, sm;
        const float ta = dot_bf16(AZA + (size_t)row * DM, WBT_A + (size_t)pc * DM, 1024, sa);
        const float tb = dot_bf16(AZB + (size_t)row * DM, WBT_A + (size_t)pc * DM + 1024, 2048, sb);
        const float tm = dot_bf16(AZM + (size_t)row * DM, WBT_A + (size_t)pc * DM + 3072, 1024, sm);
        const float ga = bf1(P + (size_t)row * N_IN + C_GA + col), gb = bf1(P + (size_t)row * N_IN + C_GB + col), gm = bf1(P + (size_t)row * N_IN + C_GM + col);
        float u = rbf(ga * ta); u = rbf(u + gb * tb); u = rbf(u + gm * tm);
        const float got = bf1(U + (size_t)row * DM + col);
        if (!(fabsf(got - u) <= 0.02f * fabsf(u) + 2e-4f * (sa + sb + sm) + 1e-5f)) atomicAdd(ctl + 18, 1u);
    }
    xcd_barrier(bar);
#endif

    {
        pg8::StaticOrder S; S.init(M_TOK / 256, DM / 256, G, bx);
        pg8::Gemm g{U, WOT, DM, DM, DM}; EpiOut E{x_prompt, x_sample, args.out};
        pg8::gemm_phase<EpiOut>(lds, g, S, E);
    }
    xcd_barrier(bar);


#if SELFCHECK
    {
        const unsigned gt = (unsigned)bx * 512u + (unsigned)tid; const unsigned hsh = hash32(gt * 2654435761u + 4242u);
        const int row = (int)(hsh % (unsigned)M_TOK); const int col = (int)(hash32(hsh + 5u) % (unsigned)DM); float sa;
        const float t = dot_bf16(U + (size_t)row * DM, WOT + (size_t)col * DM, DM, sa);
        const float xv = row < M_PROMPT ? x_prompt[(size_t)row * DM + col] : x_sample[(size_t)(row - M_PROMPT) * DM + col];
        const float got = args.out[(size_t)row * DM + col];
        if (!(fabsf(got - (xv + t)) <= 1e-4f * sa + 1e-5f)) atomicAdd(ctl + 19, 1u);
    }
    xcd_barrier(bar);
#endif

    {
        const unsigned bad = __hip_atomic_load(ctl + CW_BAR + XB_TMO, __ATOMIC_RELAXED, __HIP_MEMORY_SCOPE_AGENT);
        for (int m = gw; m < M_TOK; m += NGW) {
            f32x4* xr = (f32x4*)(args.out + (size_t)m * DM) + lane; f32x4 v[16]; float s = 0.f;
#pragma unroll
            for (int j = 0; j < 16; ++j) { v[j] = xr[64 * j]; s += (v[j][0] * v[j][0] + v[j][1] * v[j][1]) + (v[j][2] * v[j][2] + v[j][3] * v[j][3]); }
            float rstd = 1.0f / sqrtf(wave_sum(s) * (1.0f / DM) + NORM_EPS);
            if (bad) rstd = __builtin_nanf("");
#if SELFCHECK
            { const unsigned f1 = __hip_atomic_load(ctl + 16, __ATOMIC_RELAXED, __HIP_MEMORY_SCOPE_AGENT), f2 = __hip_atomic_load(ctl + 17, __ATOMIC_RELAXED, __HIP_MEMORY_SCOPE_AGENT), f3 = __hip_atomic_load(ctl + 18, __ATOMIC_RELAXED, __HIP_MEMORY_SCOPE_AGENT), f4 = __hip_atomic_load(ctl + 19, __ATOMIC_RELAXED, __HIP_MEMORY_SCOPE_AGENT);
              const unsigned a0 = __hip_atomic_load(ctl + 20, __ATOMIC_RELAXED, __HIP_MEMORY_SCOPE_AGENT), a1 = __hip_atomic_load(ctl + 21, __ATOMIC_RELAXED, __HIP_MEMORY_SCOPE_AGENT), a2 = __hip_atomic_load(ctl + 22, __ATOMIC_RELAXED, __HIP_MEMORY_SCOPE_AGENT), a3 = __hip_atomic_load(ctl + 23, __ATOMIC_RELAXED, __HIP_MEMORY_SCOPE_AGENT), a4 = __hip_atomic_load(ctl + 24, __ATOMIC_RELAXED, __HIP_MEMORY_SCOPE_AGENT);
              rstd *= 1.0f + (a0 > 100u ? 0.1f : 0.f) + (a1 > 100u ? 0.2f : 0.f) + (a2 > 100u ? 0.4f : 0.f) + (a3 ? 0.8f : 0.f) + (a4 ? 1.6f : 0.f) + ((f1 | f2 | f3 | f4) ? 3.2f : 0.f); }
#endif
            const f32x4* gr = (const f32x4*)g_final + lane;
#pragma unroll
            for (int j = 0; j < 16; ++j) { const f32x4 g = gr[64 * j]; xr[64 * j] = v[j] * rstd * g; }
        }
    }
}

extern "C" void kernel_launch(void* const* d_in, const int* in_sizes, int n_in, void* d_out, int out_size, void* d_ws, size_t ws_size, hipStream_t stream) {
    static int grid = 0;
    if (grid == 0) {
        if (n_in != 12 || out_size != M_TOK * DM || ws_size < WS_END) { fprintf(stderr, "kernel_launch: unexpected shapes (n_in %d, out %d, ws %zu)\n", n_in, out_size, ws_size); grid = -1; return; }
        int dev = 0, cus = 0, per_cu = 0;
        if (hipGetDevice(&dev) != hipSuccess || hipDeviceGetAttribute(&cus, hipDeviceAttributeMultiprocessorCount, dev) != hipSuccess) { grid = -1; return; }
        if (hipFuncSetAttribute((const void*)fwd_kernel, hipFuncAttributeMaxDynamicSharedMemorySize, LDS_BYTES) != hipSuccess) { fprintf(stderr, "kernel_launch: hipFuncSetAttribute failed\n"); grid = -1; return; }
        if (hipOccupancyMaxActiveBlocksPerMultiprocessor(&per_cu, (const void*)fwd_kernel, NWAVES * 64, LDS_BYTES) != hipSuccess || per_cu < 1) { fprintf(stderr, "kernel_launch: occupancy query says %d\n", per_cu); (void)hipGetLastError(); if (per_cu < 1) { grid = -1; return; } }
        grid = cus;
    }
    if (grid < 0) return;
    if (hipMemsetAsync((char*)d_ws + WS_CTL, 0, CTL_ZERO_BYTES, stream) != hipSuccess) return;
    Args a{};
    for (int i = 0; i < 12; ++i) a.in[i] = (const float*)d_in[i];
    a.out = (float*)d_out; a.ws = (unsigned char*)d_ws;
    hipLaunchKernelGGL(fwd_kernel, dim3(grid), dim3(NWAVES * 64), LDS_BYTES, stream, a);
}
```
